# Optimizing an MI355X kernel written in HIP

```python
import jax, jax.numpy as jnp
from jax import lax
import numpy as np

D_MODEL = 2048
BATCH = 2
SEQ = 8192
DEPTH = 1

GRID_W = 64
NA_HEADS = 8
NA_HEAD_DIM = 128
NA_WIDTH = NA_HEADS * NA_HEAD_DIM
NA_KH = 8
NA_KW = 16
NA_COLS = 3 * NA_WIDTH
RWKV_HEAD_DIM = 64
RWKV_HEADS = 16
RWKV_WIDTH = RWKV_HEADS * RWKV_HEAD_DIM
DECAY_LORA = 96
AAA_LORA = 96
GATE_LORA = 256
RWKV_GN_EPS = 64e-5
RWKV_SIZES = (RWKV_WIDTH, RWKV_WIDTH, RWKV_WIDTH, DECAY_LORA, DECAY_LORA, AAA_LORA, AAA_LORA, GATE_LORA)
RWKV_COLS = 3 * RWKV_WIDTH + 2 * DECAY_LORA + 2 * AAA_LORA + GATE_LORA
GATE_COLS = 2 * D_MODEL
IN_COLS = NA_COLS + RWKV_COLS + GATE_COLS
PEER_HEADS = 8
PEER_DQ = 256
PEER_N_KEYS = 128
PEER_N_EXPERTS = PEER_N_KEYS * PEER_N_KEYS
PEER_TOPK = 16
PEER_CHUNK = 128
NORM_EPS = 1e-6

kernel_name = "hybrid_na_rwkv7_peer_block"


def _split(z, sizes):
    parts, start = [], 0
    for s in sizes:
        parts.append(z[..., start:start + s])
        start += s
    return parts


def rms_norm(x, w):
    xf = x.astype(jnp.float32)
    y = xf * lax.rsqrt(jnp.mean(xf * xf, axis=-1, keepdims=True) + NORM_EPS)
    return y.astype(x.dtype) * w


def neighbourhood_attention(q, k, v, rpb):
    B, S, H, Dh = q.shape
    rows = S // GRID_W
    kh = min(NA_KH, rows)
    q_g = q.reshape(B, rows, GRID_W, H, Dh)
    k_g = k.reshape(B, rows, GRID_W, H, Dh)
    v_g = v.reshape(B, rows, GRID_W, H, Dh)
    row_q = jnp.arange(rows)
    row_start = jnp.clip(row_q - kh // 2, 0, rows - kh)
    row_idx = row_start[:, None] + jnp.arange(kh)
    k_band = k_g[:, row_idx]
    v_band = v_g[:, row_idx]
    logits = jnp.einsum('biqhd,birkhd->bhiqrk', q_g, k_band).astype(jnp.float32) * (Dh ** -0.5)
    col = jnp.arange(GRID_W)
    col_start = jnp.clip(col - NA_KW // 2, 0, GRID_W - NA_KW)
    col_mask = (col[None, :] >= col_start[:, None]) & (col[None, :] < col_start[:, None] + NA_KW)
    dr = row_idx - row_q[:, None] + NA_KH - 1
    dc = jnp.clip(col[None, :] - col[:, None], -(NA_KW - 1), NA_KW - 1) + NA_KW - 1
    bias = rpb[:, dr[:, None, :, None], dc[None, :, None, :]]
    logits = jnp.where(col_mask[:, None, :], logits + bias.astype(jnp.float32)[None], -jnp.inf)
    probs = jax.nn.softmax(logits.reshape(B, H, rows, GRID_W, kh * GRID_W), axis=-1)
    probs = probs.reshape(B, H, rows, GRID_W, kh, GRID_W).astype(v.dtype)
    out = jnp.einsum('bhiqrk,birkhd->biqhd', probs, v_band)
    return out.reshape(B, S, H * Dh)


def centred_token_shift(y, mu):
    prev = jnp.pad(y[:, :-1], ((0, 0), (1, 0), (0, 0)))
    nxt = jnp.pad(y[:, 1:], ((0, 0), (0, 1), (0, 0)))
    return y + mu[0] * (prev - y) + mu[1] * (nxt - y)


def rwkv7_bidirectional(zb, mu, w0, w2, a0, a2, g2, k_k, k_a, r_k, ln_w, ln_b):
    B, S, _ = zb.shape
    H, N, C = RWKV_HEADS, RWKV_HEAD_DIM, RWKV_WIDTH
    f32 = jnp.float32
    zb = centred_token_shift(zb, mu)
    r, k, v, wd_f, wd_b, ad_f, ad_b, gd = _split(zb, RWKV_SIZES)
    wd = jnp.stack([wd_f, wd_b])
    ad = jnp.stack([ad_f, ad_b])
    w_logit = w0[:, None, None, :] + jnp.einsum('nbsr,nrc->nbsc', jnp.tanh(wd), w2)
    decay = jnp.exp(-jnp.exp(-jax.nn.softplus(-w_logit.astype(f32)) - 0.5))
    iclr = jax.nn.sigmoid((a0[:, None, None, :] + jnp.einsum('nbsr,nrc->nbsc', ad, a2)).astype(f32))
    g = (jax.nn.sigmoid(gd) @ g2).astype(f32)
    rf, kf, vf = r.astype(f32), k.astype(f32), v.astype(f32)
    kk = (kf * k_k.astype(f32)).reshape(B, S, H, N)
    kk = kk / jnp.maximum(jnp.sqrt(jnp.sum(kk * kk, axis=-1, keepdims=True)), 1e-12)
    kk = kk.reshape(B, S, C)
    k_dir = kf[None] * (1.0 + (iclr - 1.0) * k_a.astype(f32))
    b_dir = kk[None] * iclr

    def directional(t):
        t = jnp.stack([t[0], jnp.flip(t[1], axis=1)])
        return jnp.moveaxis(t.reshape(2, B, S, H, N), 2, 0)

    def shared(t):
        return directional(jnp.stack([t, t]))

    xs = (shared(rf), directional(decay), directional(k_dir), shared(vf), shared(-kk), directional(b_dir))

    def step(state, inp):
        r_t, w_t, k_t, v_t, negkk_t, b_t = inp
        sa = jnp.einsum('nbhvk,nbhk->nbhv', state, negkk_t)
        state = state * w_t[..., None, :] + sa[..., :, None] * b_t[..., None, :] + v_t[..., :, None] * k_t[..., None, :]
        return state, jnp.einsum('nbhvk,nbhk->nbhv', state, r_t)

    state0 = jnp.zeros((2, B, H, N, N), f32)
    _, o = lax.scan(step, state0, xs)
    o = jnp.moveaxis(o[:, 0] + jnp.flip(o[:, 1], axis=0), 0, 1)
    mean = jnp.mean(o, axis=-1, keepdims=True)
    var = jnp.mean(jnp.square(o - mean), axis=-1, keepdims=True)
    o = ((o - mean) * lax.rsqrt(var + RWKV_GN_EPS)).reshape(B, S, C) * ln_w.astype(f32) + ln_b.astype(f32)
    bonus = jnp.sum(rf.reshape(B, S, H, N) * kf.reshape(B, S, H, N) * r_k.astype(f32), axis=-1, keepdims=True) * vf.reshape(B, S, H, N)
    y = (o + bonus.reshape(B, S, C)) * g
    return y.astype(zb.dtype)


def peer_ffn(u, w_q, sub_k1, sub_k2, exp_u, exp_v):
    B, S, D = u.shape
    T = B * S
    half = PEER_DQ // 2
    q = (u @ w_q).reshape(T, PEER_HEADS, PEER_DQ)
    s1 = jnp.einsum('thd,nd->thn', q[..., :half], sub_k1).astype(jnp.float32)
    s2 = jnp.einsum('thd,nd->thn', q[..., half:], sub_k2).astype(jnp.float32)
    v1, i1 = lax.top_k(s1, PEER_TOPK)
    v2, i2 = lax.top_k(s2, PEER_TOPK)
    cand_s = (v1[..., :, None] + v2[..., None, :]).reshape(T, PEER_HEADS, PEER_TOPK * PEER_TOPK)
    cand_i = (i1[..., :, None] * PEER_N_KEYS + i2[..., None, :]).reshape(T, PEER_HEADS, PEER_TOPK * PEER_TOPK)
    top_s, pos = lax.top_k(cand_s, PEER_TOPK)
    expert_idx = jnp.take_along_axis(cand_i, pos, axis=-1)
    gate = jax.nn.softmax(top_s, axis=-1).astype(u.dtype)
    n_chunks = T // PEER_CHUNK

    def chunk(args):
        xc, ec, gc = args
        hidden = jax.nn.gelu(jnp.einsum('cd,chkd->chk', xc, exp_u[ec]), approximate=False) * gc
        return jnp.einsum('chk,chkd->cd', hidden, exp_v[ec])

    out = lax.map(chunk, (u.reshape(n_chunks, PEER_CHUNK, D),
                          expert_idx.reshape(n_chunks, PEER_CHUNK, PEER_HEADS, PEER_TOPK),
                          gate.reshape(n_chunks, PEER_CHUNK, PEER_HEADS, PEER_TOPK)))
    return out.reshape(B, S, D)


def hybrid_block(x, c, ada_w, ada_b, norm1_w, norm2_w, w_in, b_gate, na_q_norm_w, na_k_norm_w, na_rpb,
                 rwkv_mu, rwkv_w0, rwkv_w2, rwkv_a0, rwkv_a2, rwkv_g2, rwkv_k_k, rwkv_k_a, rwkv_r_k,
                 rwkv_ln_w, rwkv_ln_b, w_branch_a, w_branch_b, w_out, peer_w_q, peer_sub_k1, peer_sub_k2,
                 peer_u, peer_v):
    B, S, D = x.shape
    mod = jax.nn.silu(c) @ ada_w + ada_b
    shift1, scale1, gate1, shift2, scale2, gate2 = jnp.split(mod[:, None, :], 6, axis=-1)
    u = rms_norm(x, norm1_w) * (1.0 + scale1) + shift1
    z = u @ w_in
    za, zb, zg = _split(z, (NA_COLS, RWKV_COLS, GATE_COLS))
    q, k, v = jnp.split(za, 3, axis=-1)
    q = rms_norm(q.reshape(B, S, NA_HEADS, NA_HEAD_DIM), na_q_norm_w)
    k = rms_norm(k.reshape(B, S, NA_HEADS, NA_HEAD_DIM), na_k_norm_w)
    v = v.reshape(B, S, NA_HEADS, NA_HEAD_DIM)
    o_a = neighbourhood_attention(q, k, v, na_rpb)
    o_b = rwkv7_bidirectional(zb, rwkv_mu, rwkv_w0, rwkv_w2, rwkv_a0, rwkv_a2, rwkv_g2,
                              rwkv_k_k, rwkv_k_a, rwkv_r_k, rwkv_ln_w, rwkv_ln_b)
    gates = jax.nn.sigmoid((zg + b_gate).astype(jnp.float32)).astype(x.dtype)
    gate_a, gate_b = jnp.split(gates, 2, axis=-1)
    merged = gate_a * (o_a @ w_branch_a) + gate_b * (o_b @ w_branch_b)
    x = x + gate1 * (merged @ w_out)
    u2 = rms_norm(x, norm2_w) * (1.0 + scale2) + shift2
    x = x + gate2 * peer_ffn(u2, peer_w_q, peer_sub_k1, peer_sub_k2, peer_u, peer_v)
    return x


def setup_inputs(seed: int = 0) -> dict:
    key = jax.random.key(seed)
    ks = iter(jax.random.split(key, 40))
    L = DEPTH

    def nrm(shape, scale):
        return scale * jax.random.normal(next(ks), shape, jnp.float32)

    def unif(shape, lo, hi):
        return jax.random.uniform(next(ks), shape, jnp.float32, minval=lo, maxval=hi)

    return {
        "x": nrm((BATCH, SEQ, D_MODEL), 1.0),
        "c": nrm((BATCH, D_MODEL), 1.0),
        "ada_w": nrm((L, D_MODEL, 6 * D_MODEL), 0.5 * D_MODEL ** -0.5),
        "ada_b": nrm((L, 6 * D_MODEL), 0.01),
        "norm1_w": 1.0 + nrm((L, D_MODEL), 0.02),
        "norm2_w": 1.0 + nrm((L, D_MODEL), 0.02),
        "w_in": nrm((L, D_MODEL, IN_COLS), D_MODEL ** -0.5),
        "b_gate": nrm((L, GATE_COLS), 0.1),
        "na_q_norm_w": 1.0 + nrm((L, NA_HEAD_DIM), 0.02),
        "na_k_norm_w": 1.0 + nrm((L, NA_HEAD_DIM), 0.02),
        "na_rpb": nrm((L, NA_HEADS, 2 * NA_KH - 1, 2 * NA_KW - 1), 0.1),
        "rwkv_mu": unif((L, 2, RWKV_COLS), 0.0, 0.5),
        "rwkv_w0": unif((L, 2, RWKV_WIDTH), -3.0, 1.0),
        "rwkv_w2": nrm((L, 2, DECAY_LORA, RWKV_WIDTH), DECAY_LORA ** -0.5),
        "rwkv_a0": nrm((L, 2, RWKV_WIDTH), 0.5),
        "rwkv_a2": nrm((L, 2, AAA_LORA, RWKV_WIDTH), AAA_LORA ** -0.5),
        "rwkv_g2": nrm((L, GATE_LORA, RWKV_WIDTH), GATE_LORA ** -0.5),
        "rwkv_k_k": 0.85 + nrm((L, RWKV_WIDTH), 0.02),
        "rwkv_k_a": 1.0 + nrm((L, RWKV_WIDTH), 0.02),
        "rwkv_r_k": nrm((L, RWKV_HEADS, RWKV_HEAD_DIM), 0.1),
        "rwkv_ln_w": 1.0 + nrm((L, RWKV_WIDTH), 0.02),
        "rwkv_ln_b": nrm((L, RWKV_WIDTH), 0.01),
        "w_branch_a": nrm((L, NA_WIDTH, D_MODEL), NA_WIDTH ** -0.5),
        "w_branch_b": nrm((L, RWKV_WIDTH, D_MODEL), RWKV_WIDTH ** -0.5),
        "w_out": nrm((L, D_MODEL, D_MODEL), D_MODEL ** -0.5),
        "peer_w_q": nrm((L, D_MODEL, PEER_HEADS * PEER_DQ), D_MODEL ** -0.5),
        "peer_sub_k1": nrm((L, PEER_N_KEYS, PEER_DQ // 2), (PEER_DQ // 2) ** -0.5),
        "peer_sub_k2": nrm((L, PEER_N_KEYS, PEER_DQ // 2), (PEER_DQ // 2) ** -0.5),
        "peer_u": nrm((L, PEER_N_EXPERTS, D_MODEL), D_MODEL ** -0.5),
        "peer_v": nrm((L, PEER_N_EXPERTS, D_MODEL), 0.5),
    }


def reference(x, c, ada_w, ada_b, norm1_w, norm2_w, w_in, b_gate, na_q_norm_w, na_k_norm_w, na_rpb,
              rwkv_mu, rwkv_w0, rwkv_w2, rwkv_a0, rwkv_a2, rwkv_g2, rwkv_k_k, rwkv_k_a, rwkv_r_k,
              rwkv_ln_w, rwkv_ln_b, w_branch_a, w_branch_b, w_out, peer_w_q, peer_sub_k1, peer_sub_k2,
              peer_u, peer_v):
    h = x
    for layer in range(DEPTH):
        h = hybrid_block(h, c, ada_w[layer], ada_b[layer], norm1_w[layer], norm2_w[layer], w_in[layer],
                         b_gate[layer], na_q_norm_w[layer], na_k_norm_w[layer], na_rpb[layer],
                         rwkv_mu[layer], rwkv_w0[layer], rwkv_w2[layer], rwkv_a0[layer], rwkv_a2[layer],
                         rwkv_g2[layer], rwkv_k_k[layer], rwkv_k_a[layer], rwkv_r_k[layer],
                         rwkv_ln_w[layer], rwkv_ln_b[layer], w_branch_a[layer], w_branch_b[layer],
                         w_out[layer], peer_w_q[layer], peer_sub_k1[layer], peer_sub_k2[layer],
                         peer_u[layer], peer_v[layer])
    return h
```

```cpp
#include <hip/hip_runtime.h>
#include <cstdio>
#include <cstdint>
#ifndef MK_PER_PHASE
#define MK_PER_PHASE 0
#endif
#ifndef DUP_PHASE
#define DUP_PHASE -1
#endif
namespace pg8 {
#define PG8_LAS __attribute__((address_space(3)))
typedef unsigned short bf16_t;
typedef short bf16x8 __attribute__((ext_vector_type(8)));
typedef float f32x4 __attribute__((ext_vector_type(4)));
typedef unsigned u32x4 __attribute__((ext_vector_type(4)));
constexpr int BM = 256, BK = 64, HALF = 128, HTB = HALF * BK * 2  , STAGE_BYTES = 8 * HTB, NXCD = 8, WGM = 8;

__host__ __device__ __forceinline__ int lds_byte(int r, int c) { const int st = (r >> 4) * 2 + (c >> 5), rr = r & 15, cc = c & 31, ob = rr * 64 + cc * 2; return st * 1024 + (ob ^ (((ob >> 9) & 1) << 5)); }
__host__ __device__ __forceinline__ void stage_rc(int b, int& R, int& C) { const int st = b / 1024, sb = b % 1024, swz = sb ^ (((sb >> 9) & 1) << 5); R = (st >> 1) * 16 + swz / 64; C = (st & 1) * 32 + (swz % 64) / 2; }
__host__ __device__ __forceinline__ int perm32(int rho) { const int n = rho >> 4, i = rho & 15; return 8 * (i >> 2) + 4 * n + (i & 3); }

struct Unit { int pm, pn; };
struct Gemm { const bf16_t* A; const bf16_t* Bt; int M, N, K; const bf16_t* A2; const bf16_t* Bt2; unsigned f8sb, f8sa; };
typedef int i32x4 __attribute__((ext_vector_type(4)));
typedef int i32x8 __attribute__((ext_vector_type(8)));
__device__ __forceinline__ i32x8 cat8(bf16x8 a, bf16x8 b) { return __builtin_shufflevector(__builtin_bit_cast(i32x4, a), __builtin_bit_cast(i32x4, b), 0, 1, 2, 3, 4, 5, 6, 7); }

struct StaticOrder {
    int nM, nN, nwg, G, c;
    __host__ __device__ void init(int M, int N, int G_, int c_) { nM = M / BM; nN = N / BM; nwg = nM * nN; G = G_; c = c_; }
    __host__ __device__ bool next(int i, Unit& u) const {
        const long L = (long)i * G + c; if (L >= nwg) return false;
        int wgid = (int)L; { const int q = nwg / NXCD, r = nwg % NXCD, xcd = wgid % NXCD, off = wgid / NXCD; wgid = (xcd < r ? xcd * (q + 1) : r * (q + 1) + (xcd - r) * q) + off; }
        const int nig = WGM * nN, gid = wgid / nig, fm = gid * WGM, gsz = (nM - fm) < WGM ? (nM - fm) : WGM;
        u.pm = fm + ((wgid % nig) % gsz); u.pn = (wgid % nig) / gsz; return true;
    }
    __device__ __forceinline__ size_t a_off(const Unit&) const { return 0; }
    __device__ __forceinline__ void a_ready(const Unit&) const {}
    __device__ __forceinline__ void done(const Unit&) const {}
};
struct GroupedOrder : StaticOrder { size_t a_stride; __device__ __forceinline__ size_t a_off(const Unit& u) const { return (size_t)(u.pn >> 2) * a_stride; } };
__device__ __forceinline__ unsigned cvt_pk_bf16(float lo, float hi) { unsigned r; asm volatile("v_cvt_pk_bf16_f32 %0, %1, %2" : "=v"(r) : "v"(lo), "v"(hi)); return r; }
typedef float f32x2 __attribute__((ext_vector_type(2)));
__device__ __forceinline__ float sigm(float x) { return 1.0f / (1.0f + __expf(-x)); }
__device__ __forceinline__ float bflo(unsigned u) { return __uint_as_float(u << 16); }
__device__ __forceinline__ float bfhi(unsigned u) { return __uint_as_float(u & 0xffff0000u); }

struct EpiZ {
    static constexpr bool PERM = true, AFTER_DRAIN = false;
    bf16_t *ZA, *ZB, *ZG; const float* bgate;
    __device__ __forceinline__ void operator()(const f32x4 (&acc)[2][2][4][2], const Unit& u, int wr, int wc, int fr, int fq) const {
        const int row0 = u.pm * BM + wr * 64 + fr;
        bf16_t* base; int ldc, colt; bool gate = false;
        if (u.pn < 12) { base = ZA; ldc = 3072; colt = u.pn * 256; }
        else if (u.pn < 27) { base = ZB; ldc = 3840; colt = (u.pn - 12) * 256; }
        else { base = ZG; ldc = 4096; colt = (u.pn - 27) * 256; gate = true; }
        const int col0 = colt + wc * 32 + 8 * fq;
        f32x4 bv[2][2];
#pragma unroll
        for (int bj = 0; bj < 2; ++bj)
#pragma unroll
            for (int n = 0; n < 2; ++n) bv[bj][n] = gate ? *(const f32x4*)(bgate + col0 + bj * HALF + 4 * n) : (f32x4){0.f, 0.f, 0.f, 0.f};
#pragma unroll
        for (int ai = 0; ai < 2; ++ai)
#pragma unroll
            for (int m = 0; m < 4; ++m) { bf16_t* rowp = base + (size_t)(row0 + ai * HALF + m * 16) * ldc + col0;
#pragma unroll
                for (int bj = 0; bj < 2; ++bj) { f32x4 v0 = acc[ai][bj][m][0] + bv[bj][0], v1 = acc[ai][bj][m][1] + bv[bj][1];
                    if (gate) {
#pragma unroll
                        for (int j = 0; j < 4; ++j) { v0[j] = sigm(v0[j]); v1[j] = sigm(v1[j]); } }
                    u32x4 w; w.x = cvt_pk_bf16(v0[0], v0[1]); w.y = cvt_pk_bf16(v0[2], v0[3]); w.z = cvt_pk_bf16(v1[0], v1[1]); w.w = cvt_pk_bf16(v1[2], v1[3]);
                    *(u32x4*)(rowp + bj * HALF) = w; } }
    }
};
template <int MODE> struct EpiAct {
    static constexpr bool PERM = true, AFTER_DRAIN = false;
    bf16_t* O; int ldc; const float* bias;
    __device__ __forceinline__ void operator()(const f32x4 (&acc)[2][2][4][2], const Unit& u, int wr, int wc, int fr, int fq) const {
        const int row0 = u.pm * BM + wr * 64 + fr, col0 = u.pn * BM + wc * 32 + 8 * fq;
#pragma unroll
        for (int ai = 0; ai < 2; ++ai)
#pragma unroll
            for (int m = 0; m < 4; ++m) { bf16_t* rowp = O + (size_t)(row0 + ai * HALF + m * 16) * ldc + col0;
#pragma unroll
                for (int bj = 0; bj < 2; ++bj) { f32x4 v0 = acc[ai][bj][m][0], v1 = acc[ai][bj][m][1];
                    if (MODE != 0) { v0 += *(const f32x4*)(bias + col0 + bj * HALF); v1 += *(const f32x4*)(bias + col0 + bj * HALF + 4); }
                    if (MODE != 0) {
#pragma unroll
                        for (int j = 0; j < 4; ++j) { v0[j] = sigm(v0[j]); v1[j] = sigm(v1[j]); if (MODE == 2) { v0[j] *= -0.60653066f; v1[j] *= -0.60653066f; } } }
                    u32x4 w; w.x = cvt_pk_bf16(v0[0], v0[1]); w.y = cvt_pk_bf16(v0[2], v0[3]); w.z = cvt_pk_bf16(v1[0], v1[1]); w.w = cvt_pk_bf16(v1[2], v1[3]);
                    *(u32x4*)(rowp + bj * HALF) = w; } }
    }
};
template <bool ADD> struct EpiGate {
    static constexpr bool PERM = true, AFTER_DRAIN = false;
    bf16_t* O; const bf16_t* G; int gcol; const bf16_t* T;
    __device__ __forceinline__ void operator()(const f32x4 (&acc)[2][2][4][2], const Unit& u, int wr, int wc, int fr, int fq) const {
        const int row0 = u.pm * BM + wr * 64 + fr, col0 = u.pn * BM + wc * 32 + 8 * fq;
#pragma unroll
        for (int ai = 0; ai < 2; ++ai)
#pragma unroll
            for (int m = 0; m < 4; ++m) { const size_t r = (size_t)(row0 + ai * HALF + m * 16);
#pragma unroll
                for (int bj = 0; bj < 2; ++bj) { const int c = col0 + bj * HALF;
                    const u32x4 g = *(const u32x4*)(G + r * 4096 + gcol + c);
                    f32x4 v0 = acc[ai][bj][m][0], v1 = acc[ai][bj][m][1];
                    v0[0] *= bflo(g.x); v0[1] *= bfhi(g.x); v0[2] *= bflo(g.y); v0[3] *= bfhi(g.y); v1[0] *= bflo(g.z); v1[1] *= bfhi(g.z); v1[2] *= bflo(g.w); v1[3] *= bfhi(g.w);
                    if (ADD) { const u32x4 t = *(const u32x4*)(T + r * 2048 + c);
                        v0[0] += bflo(t.x); v0[1] += bfhi(t.x); v0[2] += bflo(t.y); v0[3] += bfhi(t.y); v1[0] += bflo(t.z); v1[1] += bfhi(t.z); v1[2] += bflo(t.w); v1[3] += bfhi(t.w); }
                    u32x4 w; w.x = cvt_pk_bf16(v0[0], v0[1]); w.y = cvt_pk_bf16(v0[2], v0[3]); w.z = cvt_pk_bf16(v1[0], v1[1]); w.w = cvt_pk_bf16(v1[2], v1[3]);
                    *(u32x4*)(O + r * 2048 + c) = w; } }
    }
};
struct EpiRes {
    static constexpr bool PERM = false, AFTER_DRAIN = false;
    const float* X; float* OUT; const float* gate; int gstride;
    __device__ __forceinline__ void operator()(const f32x4 (&acc)[2][2][4][2], const Unit& u, int wr, int wc, int fr, int fq) const {
        const int row0 = u.pm * BM + wr * 64 + fr, col0 = u.pn * BM + wc * 32 + 4 * fq;
        const int b = (u.pm >= 32) ? 1 : 0;
        f32x4 gv[2][2];
#pragma unroll
        for (int bj = 0; bj < 2; ++bj)
#pragma unroll
            for (int n = 0; n < 2; ++n) gv[bj][n] = X ? *(const f32x4*)(gate + (size_t)b * gstride + col0 + bj * HALF + n * 16) : (f32x4){1.f, 1.f, 1.f, 1.f};
#pragma unroll
        for (int ai = 0; ai < 2; ++ai)
#pragma unroll
            for (int m = 0; m < 4; ++m) { const size_t off = (size_t)(row0 + ai * HALF + m * 16) * 2048 + col0;
#pragma unroll
                for (int bj = 0; bj < 2; ++bj)
#pragma unroll
                    for (int n = 0; n < 2; ++n) { f32x4 o = acc[ai][bj][m][n] * gv[bj][n];
                        if (X) o += *(const f32x4*)(X + off + bj * HALF + n * 16);
                        *(f32x4*)(OUT + off + bj * HALF + n * 16) = o; } }
    }
};
struct EpiLora {
    static constexpr bool PERM = true, AFTER_DRAIN = false;
    bf16_t* O[5]; const float* bias[5];
    __device__ __forceinline__ void operator()(const f32x4 (&acc)[2][2][4][2], const Unit& u, int wr, int wc, int fr, int fq) const {
        const int grp = u.pn >> 2, mode = (grp < 2) ? 2 : ((grp < 4) ? 1 : 0);
        const int row0 = u.pm * BM + wr * 64 + fr, col0 = (u.pn & 3) * BM + wc * 32 + 8 * fq;
        bf16_t* Og = O[0]; const float* bg = bias[0];
        if (grp == 1) { Og = O[1]; bg = bias[1]; } else if (grp == 2) { Og = O[2]; bg = bias[2]; } else if (grp == 3) { Og = O[3]; bg = bias[3]; } else if (grp == 4) { Og = O[4]; bg = bias[4]; }
#pragma unroll
        for (int ai = 0; ai < 2; ++ai)
#pragma unroll
            for (int m = 0; m < 4; ++m) { bf16_t* rowp = Og + (size_t)(row0 + ai * HALF + m * 16) * 1024 + col0;
#pragma unroll
                for (int bj = 0; bj < 2; ++bj) { f32x4 v0 = acc[ai][bj][m][0], v1 = acc[ai][bj][m][1];
                    if (mode != 0) { v0 += *(const f32x4*)(bg + col0 + bj * HALF); v1 += *(const f32x4*)(bg + col0 + bj * HALF + 4);
                        const float sc = (mode == 2) ? -0.60653066f : 1.0f;
#pragma unroll
                        for (int j = 0; j < 4; ++j) { v0[j] = sigm(v0[j]) * sc; v1[j] = sigm(v1[j]) * sc; } }
                    u32x4 w; w.x = cvt_pk_bf16(v0[0], v0[1]); w.y = cvt_pk_bf16(v0[2], v0[3]); w.z = cvt_pk_bf16(v1[0], v1[1]); w.w = cvt_pk_bf16(v1[2], v1[3]);
                    *(u32x4*)(rowp + bj * HALF) = w; } }
    }
};
typedef unsigned u32x2 __attribute__((ext_vector_type(2)));
__device__ __forceinline__ float c448(float x) { return __builtin_amdgcn_fmed3f(x, -448.f, 448.f); }
struct EpiGate2 {
    static constexpr bool PERM = true, AFTER_DRAIN = false;
    bf16_t* O; const bf16_t* G;
    __device__ __forceinline__ void mid(f32x4 (&acc)[2][2][4][2], const Unit& u, int wr, int wc, int fr, int fq) const {
        const int row0 = u.pm * BM + wr * 64 + fr, col0 = u.pn * BM + wc * 32 + 8 * fq;
        unsigned off = (unsigned)(row0 * 4096 + col0) * 2u;
        const char* Gb = (const char*)G;
#pragma unroll
        for (int ai = 0; ai < 2; ++ai)
#pragma unroll
            for (int m = 0; m < 4; ++m) {
#pragma unroll
                for (int bj = 0; bj < 2; ++bj) {
                    asm volatile("" : "+v"(off));
                    const u32x4 ga = *(const u32x4*)(Gb + off + bj * 256), gb = *(const u32x4*)(Gb + off + bj * 256 + 4096);
                    f32x4& v0 = acc[ai][bj][m][0]; f32x4& v1 = acc[ai][bj][m][1];
                    v0[0] *= bflo(ga.x) * __builtin_amdgcn_rcpf(bflo(gb.x)); v0[1] *= bfhi(ga.x) * __builtin_amdgcn_rcpf(bfhi(gb.x)); v0[2] *= bflo(ga.y) * __builtin_amdgcn_rcpf(bflo(gb.y)); v0[3] *= bfhi(ga.y) * __builtin_amdgcn_rcpf(bfhi(gb.y));
                    v1[0] *= bflo(ga.z) * __builtin_amdgcn_rcpf(bflo(gb.z)); v1[1] *= bfhi(ga.z) * __builtin_amdgcn_rcpf(bfhi(gb.z)); v1[2] *= bflo(ga.w) * __builtin_amdgcn_rcpf(bflo(gb.w)); v1[3] *= bfhi(ga.w) * __builtin_amdgcn_rcpf(bfhi(gb.w));
                    asm volatile("" : "+v"(v0), "+v"(v1));
                }
                off += (m == 3) ? (unsigned)((HALF - 48) * 4096 * 2) : (unsigned)(16 * 4096 * 2);
            }
        __builtin_amdgcn_sched_barrier(0);
    }
    __device__ __forceinline__ void operator()(const f32x4 (&acc)[2][2][4][2], const Unit& u, int wr, int wc, int fr, int fq) const {
        const int row0 = u.pm * BM + wr * 64 + fr, col0 = u.pn * BM + wc * 32 + 8 * fq;
#pragma unroll
        for (int ai = 0; ai < 2; ++ai)
#pragma unroll
            for (int m = 0; m < 4; ++m) { const size_t r = (size_t)(row0 + ai * HALF + m * 16);
#pragma unroll
                for (int bj = 0; bj < 2; ++bj) { const int c = col0 + bj * HALF;
                    const u32x4 g = *(const u32x4*)(G + r * 4096 + 2048 + c);
                    f32x4 v0 = acc[ai][bj][m][0], v1 = acc[ai][bj][m][1];
                    v0[0] *= bflo(g.x); v0[1] *= bfhi(g.x); v0[2] *= bflo(g.y); v0[3] *= bfhi(g.y); v1[0] *= bflo(g.z); v1[1] *= bfhi(g.z); v1[2] *= bflo(g.w); v1[3] *= bfhi(g.w);
                    int t0 = 0, t1 = 0;
                    t0 = __builtin_amdgcn_cvt_pk_fp8_f32(c448(v0[0] * 32.f), c448(v0[1] * 32.f), t0, false); t0 = __builtin_amdgcn_cvt_pk_fp8_f32(c448(v0[2] * 32.f), c448(v0[3] * 32.f), t0, true);
                    t1 = __builtin_amdgcn_cvt_pk_fp8_f32(c448(v1[0] * 32.f), c448(v1[1] * 32.f), t1, false); t1 = __builtin_amdgcn_cvt_pk_fp8_f32(c448(v1[2] * 32.f), c448(v1[3] * 32.f), t1, true);
                    u32x2 w; w.x = (unsigned)t0; w.y = (unsigned)t1;
                    *(u32x2*)((unsigned char*)O + r * 2048 + c) = w; } }
    }
};
template <class Epi, class Sched, bool ALIGN_EPI = false, bool SP2 = false, bool DUALK = false, bool F8 = false>
__device__ __forceinline__ void gemm_phase(PG8_LAS unsigned char* lds, const Gemm g, const Sched& S, const Epi& E) {
    int tid_ = threadIdx.x; asm volatile("" : "+v"(tid_));
    const int tid = tid_, wid = __builtin_amdgcn_readfirstlane(tid >> 6), lane = tid & 63, wr = wid >> 2, wc = wid & 3, fr = lane & 15, fq = lane >> 4;
    const int K = DUALK ? g.K / 2 : g.K, nt = g.K / BK, nth = nt / 2;
    unsigned voffA[2], voffB[2];
#pragma unroll
    for (int i = 0; i < 2; ++i) { int R, C; stage_rc(tid * 16 + i * 8192, R, C); const int Rb = Epi::PERM ? ((R & ~31) + perm32(R & 31)) : R;
        voffA[i] = (unsigned)(R * K + C) * 2u; voffB[i] = (unsigned)(Rb * K + C) * 2u; }
    const size_t kstep = (size_t)(BK * 2);
    const size_t hstep = (size_t)HALF * K * 2;
    const size_t tstep = 2 * hstep;
    const unsigned ldsw = (unsigned)wid * 1024u;
    const int aoff = lds_byte(wr * 64 + fr, fq * 8), boff = lds_byte(wc * 32 + fr, fq * 8);
#define PG8_SA(b, h) (((b) * 2 + (h)) * HTB)
#define PG8_SB(b, h) ((4 + (b) * 2 + (h)) * HTB)
#define PG8_STAGE(bufoff, gbase, voff) do { _Pragma("unroll") for (int _i = 0; _i < 2; ++_i) \
        __builtin_amdgcn_global_load_lds((const unsigned*)((const char*)(gbase) + (voff)[_i]), (PG8_LAS unsigned*)(lds + (bufoff) + ldsw + _i * 8192), 16, 0, 0); } while (0)
#define PG8_LDA(dst, b, h) do { _Pragma("unroll") for (int m = 0; m < 4; ++m) { \
        if constexpr (F8) dst##8[m] = cat8(*(const PG8_LAS bf16x8*)(lds + PG8_SA(b, h) + aoff + m * 2048), *(const PG8_LAS bf16x8*)(lds + PG8_SA(b, h) + aoff + m * 2048 + 1024)); \
        else { _Pragma("unroll") for (int k = 0; k < 2; ++k) dst[m][k] = *(const PG8_LAS bf16x8*)(lds + PG8_SA(b, h) + aoff + m * 2048 + k * 1024); } } } while (0)
#define PG8_LDB(dst, b, h) do { _Pragma("unroll") for (int n = 0; n < 2; ++n) { \
        if constexpr (F8) dst##8[n] = cat8(*(const PG8_LAS bf16x8*)(lds + PG8_SB(b, h) + boff + n * 2048), *(const PG8_LAS bf16x8*)(lds + PG8_SB(b, h) + boff + n * 2048 + 1024)); \
        else { _Pragma("unroll") for (int k = 0; k < 2; ++k) dst[n][k] = *(const PG8_LAS bf16x8*)(lds + PG8_SB(b, h) + boff + n * 2048 + k * 1024); } } } while (0)
#define PG8_MMA(ai, bj, At, Bt) do { __builtin_amdgcn_s_setprio(1); _Pragma("unroll") for (int m = 0; m < 4; ++m) _Pragma("unroll") for (int n = 0; n < 2; ++n) { \
        if constexpr (F8) asm volatile("v_mfma_scale_f32_16x16x128_f8f6f4 %0, %1, %2, %0, %3, %4 op_sel_hi:[0,0,0]" : "+v"(acc[ai][bj][m][n]) : "v"(Bt##8[n]), "v"(At##8[m]), "v"(f8sb_), "v"(f8sa_));     \
        else { _Pragma("unroll") for (int k = 0; k < 2; ++k) acc[ai][bj][m][n] = __builtin_amdgcn_mfma_f32_16x16x32_bf16(Bt[n][k], At[m][k], acc[ai][bj][m][n], 0, 0, 0); } } __builtin_amdgcn_s_setprio(0); } while (0)
#define PG8_WAIT_V(n) asm volatile("s_waitcnt vmcnt(" #n ")" ::: "memory")
#define PG8_WAIT_L(n) asm volatile("s_waitcnt lgkmcnt(" #n ")" ::: "memory")
#define PG8_BAR __builtin_amdgcn_s_barrier()
#define PG8_SCHED __builtin_amdgcn_sched_barrier(0)
    Unit cur, nxt; int ui = 0;
    if (!S.next(0, cur)) return;
    f32x4 acc[2][2][4][2];
#pragma unroll
    for (int a = 0; a < 2; ++a)
#pragma unroll
        for (int b = 0; b < 2; ++b)
#pragma unroll
            for (int m = 0; m < 4; ++m)
#pragma unroll
                for (int n = 0; n < 2; ++n) acc[a][b][m][n] = (f32x4){0.f, 0.f, 0.f, 0.f};
    const unsigned f8sb_ = g.f8sb, f8sa_ = g.f8sa;
    bf16x8 At[4][2], B0[2][2], B1[2][2]; i32x8 At8[4], B08[2], B18[2];
    const char* cA = (const char*)g.A + S.a_off(cur) + (size_t)cur.pm * tstep; const char* cB = (const char*)g.Bt + (size_t)cur.pn * tstep;
    const char* cA2 = DUALK ? (const char*)g.A2 + (size_t)cur.pm * tstep : cA; const char* cB2 = DUALK ? (const char*)g.Bt2 + (size_t)cur.pn * tstep : cB;
#define PG8_TA(tt) ((DUALK && (tt) >= nth) ? cA2 + (size_t)((tt) - nth) * kstep : cA + (size_t)(tt) * kstep)
#define PG8_TB(tt) ((DUALK && (tt) >= nth) ? cB2 + (size_t)((tt) - nth) * kstep : cB + (size_t)(tt) * kstep)
    S.a_ready(cur);
    if constexpr (SP2) {
        PG8_STAGE(PG8_SB(0, 0), cB, voffB); PG8_STAGE(PG8_SB(0, 1), cB + hstep, voffB); PG8_STAGE(PG8_SA(0, 0), cA, voffA); PG8_STAGE(PG8_SA(0, 1), cA + hstep, voffA);
        if (wr == 1) PG8_BAR;
        PG8_WAIT_V(2); PG8_BAR;
        PG8_STAGE(PG8_SB(1, 0), cB + kstep, voffB); PG8_STAGE(PG8_SA(1, 0), cA + kstep, voffA); PG8_STAGE(PG8_SB(1, 1), cB + hstep + kstep, voffB);
        PG8_WAIT_V(6); PG8_BAR;
    } else {
        PG8_STAGE(PG8_SB(0, 0), cB, voffB); PG8_STAGE(PG8_SA(0, 0), cA, voffA); PG8_STAGE(PG8_SB(0, 1), cB + hstep, voffB); PG8_STAGE(PG8_SA(0, 1), cA + hstep, voffA);
        if (wr == 1) PG8_BAR;
        PG8_WAIT_V(4); PG8_BAR;
        PG8_STAGE(PG8_SB(1, 0), cB + kstep, voffB); PG8_STAGE(PG8_SA(1, 0), cA + kstep, voffA); PG8_STAGE(PG8_SB(1, 1), cB + hstep + kstep, voffB);
        PG8_WAIT_V(6); PG8_BAR;
    }
    for (;;) {
        const bool has_next = S.next(ui + 1, nxt);
        const char* nA = has_next ? (const char*)g.A + S.a_off(nxt) + (size_t)nxt.pm * tstep : cA; const char* nB = has_next ? (const char*)g.Bt + (size_t)nxt.pn * tstep : cB;
        const char* nA2 = (DUALK && has_next) ? (const char*)g.A2 + (size_t)nxt.pm * tstep : cA2; const char* nB2 = (DUALK && has_next) ? (const char*)g.Bt2 + (size_t)nxt.pn * tstep : cB2;
        for (int t = 0; t < nt; t += 2) {
            const bool last = (t == nt - 2);
            const char* a1 = PG8_TA(t + 1);
            const char* a2 = last ? nA : PG8_TA(t + 2); const char* b2 = last ? nB : PG8_TB(t + 2);
            if constexpr (DUALK) { if (t == nth) { if constexpr (F8) { asm volatile("s_nop 15\n\ts_nop 15" ::: "memory"); } E.mid(acc, cur, wr, wc, fr, fq); } }
            const char* a3 = a2 + kstep; const char* b3 = b2 + kstep;
            if (last && has_next) S.a_ready(nxt);
            if constexpr (SP2) {
            PG8_LDB(B0, 0, 0); PG8_LDB(B1, 0, 1); PG8_SCHED; PG8_LDA(At, 0, 0); PG8_STAGE(PG8_SA(1, 1), a1 + hstep, voffA);
            PG8_WAIT_V(8); PG8_WAIT_L(0); PG8_BAR; PG8_MMA(0, 0, At, B0); PG8_MMA(0, 1, At, B1); PG8_BAR; PG8_SCHED;
            PG8_LDA(At, 0, 1); PG8_STAGE(PG8_SB(0, 0), b2, voffB); PG8_STAGE(PG8_SB(0, 1), b2 + hstep, voffB); PG8_STAGE(PG8_SA(0, 0), a2, voffA);
            PG8_WAIT_V(8); PG8_WAIT_L(0); PG8_BAR; PG8_MMA(1, 0, At, B0); PG8_MMA(1, 1, At, B1); PG8_BAR; PG8_SCHED;
            PG8_LDB(B0, 1, 0); PG8_LDB(B1, 1, 1); PG8_SCHED; PG8_LDA(At, 1, 0); PG8_STAGE(PG8_SA(0, 1), a2 + hstep, voffA);
            PG8_WAIT_V(8); PG8_WAIT_L(0); PG8_BAR; PG8_MMA(0, 0, At, B0); PG8_MMA(0, 1, At, B1); PG8_BAR; PG8_SCHED;
            PG8_LDA(At, 1, 1); PG8_STAGE(PG8_SB(1, 0), b3, voffB); PG8_STAGE(PG8_SB(1, 1), b3 + hstep, voffB); PG8_STAGE(PG8_SA(1, 0), a3, voffA);
            PG8_WAIT_V(8); PG8_WAIT_L(0); PG8_BAR; PG8_MMA(1, 0, At, B0); PG8_MMA(1, 1, At, B1); PG8_BAR; PG8_SCHED;
            } else {
            PG8_LDB(B0, 0, 0); PG8_SCHED; PG8_LDA(At, 0, 0); PG8_STAGE(PG8_SA(1, 1), a1 + hstep, voffA);
            PG8_WAIT_L(8); PG8_BAR; PG8_WAIT_L(0); PG8_MMA(0, 0, At, B0); PG8_BAR; PG8_SCHED;
            PG8_LDB(B1, 0, 1); PG8_STAGE(PG8_SB(0, 0), b2, voffB);
            PG8_BAR; PG8_WAIT_L(0); PG8_MMA(0, 1, At, B1); PG8_BAR;
            PG8_LDA(At, 0, 1); PG8_STAGE(PG8_SA(0, 0), a2, voffA);
            PG8_BAR; PG8_WAIT_L(0); PG8_MMA(1, 0, At, B0); PG8_BAR; PG8_SCHED;
            PG8_STAGE(PG8_SB(0, 1), b2 + hstep, voffB);
            PG8_WAIT_V(6); PG8_BAR; PG8_MMA(1, 1, At, B1); PG8_BAR;
            PG8_LDB(B0, 1, 0); PG8_SCHED; PG8_LDA(At, 1, 0); PG8_STAGE(PG8_SA(0, 1), a2 + hstep, voffA);
            PG8_WAIT_L(8); PG8_BAR; PG8_WAIT_L(0); PG8_MMA(0, 0, At, B0); PG8_BAR; PG8_SCHED;
            PG8_LDB(B1, 1, 1); PG8_STAGE(PG8_SB(1, 0), b3, voffB);
            PG8_BAR; PG8_WAIT_L(0); PG8_MMA(0, 1, At, B1); PG8_BAR;
            PG8_LDA(At, 1, 1); PG8_STAGE(PG8_SA(1, 0), a3, voffA);
            PG8_BAR; PG8_WAIT_L(0); PG8_MMA(1, 0, At, B0); PG8_BAR; PG8_SCHED;
            PG8_STAGE(PG8_SB(1, 1), b3 + hstep, voffB);
            PG8_WAIT_V(6); PG8_BAR; PG8_MMA(1, 1, At, B1); PG8_BAR;
            }
        }
        if constexpr (ALIGN_EPI) { if (wr == 0) PG8_BAR; }
        if constexpr (F8) { asm volatile("s_nop 15\n\ts_nop 15" ::: "memory"); }
        if constexpr (!Epi::AFTER_DRAIN) { E(acc, cur, wr, wc, fr, fq); S.done(cur); }
        if (!has_next) break;
#pragma unroll
        for (int a = 0; a < 2; ++a)
#pragma unroll
            for (int b = 0; b < 2; ++b)
#pragma unroll
                for (int m = 0; m < 4; ++m)
#pragma unroll
                    for (int n = 0; n < 2; ++n) acc[a][b][m][n] = (f32x4){0.f, 0.f, 0.f, 0.f};
        cur = nxt; cA = nA; cB = nB; cA2 = nA2; cB2 = nB2; ++ui;
        if constexpr (ALIGN_EPI) { if (wr == 1) PG8_BAR; }
    }
    PG8_WAIT_V(0);
    if constexpr (!ALIGN_EPI) { if (wr == 0) PG8_BAR; }
    PG8_BAR;
    if constexpr (Epi::AFTER_DRAIN) { E.fused(acc, cur, wr, wc, fr, fq, lds, wid, lane); S.done(cur); }
#undef PG8_TA
#undef PG8_TB
#undef PG8_SA
#undef PG8_SB
#undef PG8_STAGE
#undef PG8_LDA
#undef PG8_LDB
#undef PG8_MMA
#undef PG8_WAIT_V
#undef PG8_WAIT_L
#undef PG8_BAR
#undef PG8_SCHED
}
}

constexpr int NWAVES = 8;
constexpr int DM = 2048, SEQ = 8192, MROWS = 16384;
constexpr int NZ = 11008;
constexpr int N_PHASES = 18;
constexpr size_t MiB = 1ull << 20;
constexpr size_t WS_CTL = 0, CTL_ZERO_BYTES = 1 * MiB;
constexpr int CW_BAR = 4096;
constexpr size_t WS_MOD = 256 * 1024;
constexpr size_t WS_LORA = 2 * MiB;
constexpr size_t WS_WA = 5 * MiB, WS_WB = 9 * MiB, WS_WOUT = 13 * MiB, WS_WQS = 21 * MiB;
constexpr size_t WS_WIN = 29 * MiB;
constexpr size_t WS_U16 = 72 * MiB;
constexpr size_t WS_ZA = 136 * MiB;
constexpr size_t WS_ZB = 232 * MiB;
constexpr size_t WS_R = 352 * MiB, WS_K = 384 * MiB, WS_V = 416 * MiB, WS_KK = 448 * MiB;
constexpr size_t WS_OA = 29 * MiB;
constexpr size_t WS_T = 72 * MiB;
constexpr size_t WS_LWF = 232 * MiB, WS_LWB = 264 * MiB, WS_ICF = 296 * MiB, WS_ICB = 512 * MiB, WS_G = 544 * MiB;
constexpr size_t WS_OF = 72 * MiB, WS_OBW = 104 * MiB;
constexpr size_t WS_OB16 = 296 * MiB;
constexpr size_t WS_TMPA = 352 * MiB, WS_MERGED = 416 * MiB;
constexpr size_t WS_U2 = 72 * MiB;
constexpr size_t WS_PU = 136 * MiB, WS_PV = 168 * MiB;
constexpr size_t WS_EIDX = 29 * MiB, WS_ESU = 37 * MiB, WS_EGV = 45 * MiB;
constexpr size_t WS_PSC = 200 * MiB;
constexpr size_t WS_HP = 264 * MiB;
constexpr size_t WS_GVP = 53 * MiB;
constexpr size_t WS_SC = 264 * MiB;
constexpr size_t WS_VT = 480 * MiB;
constexpr size_t WS_PHIF = 576 * MiB, WS_PHIB = 328 * MiB;
constexpr size_t WS_QS = 61 * MiB, WS_PS = 65 * MiB, WS_SST = 69 * MiB;
constexpr size_t WS_X8H = 416 * MiB, WS_X8L = 448 * MiB;
constexpr size_t WS_END = 600 * MiB;
constexpr int LDS_BYTES = 163840, MISC_OFF = 157696;

#define GAS __attribute__((address_space(1)))
#define LAS __attribute__((address_space(3)))
#define DI __device__ __forceinline__
typedef unsigned short bf16;
typedef unsigned v4u __attribute__((ext_vector_type(4)));
typedef unsigned v2u __attribute__((ext_vector_type(2)));
typedef float f32x4 __attribute__((ext_vector_type(4)));
#define LDS_WAIT() asm volatile("s_waitcnt lgkmcnt(0)" ::: "memory")
DI unsigned f2bf(float f) { unsigned u = __builtin_bit_cast(unsigned, f); return (u + 0x7fffu + ((u >> 16) & 1u)) >> 16; }
DI unsigned pk2(float lo, float hi) { return f2bf(lo) | (f2bf(hi) << 16); }
DI float bflo(unsigned u) { return __uint_as_float(u << 16); }
DI float bfhi(unsigned u) { return __uint_as_float(u & 0xffff0000u); }
DI float sigm(float x) { return 1.0f / (1.0f + __expf(-x)); }
DI float wave_sum(float v) {
#pragma unroll
    for (int o = 32; o >= 1; o >>= 1) v += __shfl_xor(v, o);
    return v;
}
DI float wave_max(float v) {
#pragma unroll
    for (int o = 32; o >= 1; o >>= 1) v = fmaxf(v, __shfl_xor(v, o));
    return v;
}
template <int CTRL> DI float dpp_mov(float v) { return __int_as_float(__builtin_amdgcn_update_dpp(0, __float_as_int(v), CTRL, 0xF, 0xF, false)); }
DI float row16_sum(float v) { v += dpp_mov<0xB1>(v); v += dpp_mov<0x4E>(v); v += dpp_mov<0x124>(v); v += dpp_mov<0x128>(v); return v; }
template <int CTRL> DI float dpp_maxf(float v) { return fmaxf(v, dpp_mov<CTRL>(v)); }
DI float row16_max(float v) { v = dpp_maxf<0xB1>(v); v = dpp_maxf<0x4E>(v); v = dpp_maxf<0x124>(v); v = dpp_maxf<0x128>(v); return v; }
DI float rdl(float v, int l) { return __uint_as_float(__builtin_amdgcn_readlane(__float_as_uint(v), l)); }
DI float wave_sum_fast(float v) { v = row16_sum(v); return (rdl(v, 0) + rdl(v, 16)) + (rdl(v, 32) + rdl(v, 48)); }
DI float wave_max_fast(float v) { v = row16_max(v); return fmaxf(fmaxf(rdl(v, 0), rdl(v, 16)), fmaxf(rdl(v, 32), rdl(v, 48))); }
typedef float f32x2 __attribute__((ext_vector_type(2)));
template <int CTRL> DI float dpp_addf(float v) { return v + dpp_mov<CTRL>(v); }
DI float group8_sum(float v) { v = dpp_addf<0xB1>(v); v = dpp_addf<0x4E>(v); v = dpp_addf<0x141>(v); return v; }
#define XB_TMO      128
#define XB_XCNT(j)  (256  + 64 * (j))
#define XB_XSUB(j)  (1280 + 64 * (j))
#define XB_XGEN(j)  (2304 + 64 * (j))
#define XB_TOP      3328
#define XB_TOPGEN   3392
#define XCD_BAR_WORDS 3456
#define XB_SPIN_CAP (1u << 18)

__device__ __forceinline__ unsigned xb_ld(unsigned* p)              { return __hip_atomic_load(p, __ATOMIC_RELAXED, __HIP_MEMORY_SCOPE_AGENT); }
__device__ __forceinline__ unsigned xb_add(unsigned* p, unsigned v) { return __hip_atomic_fetch_add(p, v, __ATOMIC_RELAXED, __HIP_MEMORY_SCOPE_AGENT); }
__device__ __forceinline__ unsigned xb_xcc_id() { return (unsigned)__builtin_amdgcn_s_getreg((3 << 11) | 20) & 0xFu; }
#define XB_SPIN(cond, bar) do { unsigned _sp = 0; while (cond) { __builtin_amdgcn_s_sleep(1); \
    if ((++_sp & 255u) == 0u) { if (xb_ld(&(bar)[XB_TMO])) break; if (_sp > XB_SPIN_CAP) { atomicAdd(&(bar)[XB_TMO], 1u); break; } } } } while (0)

struct XcdBarrier {
    unsigned* bar; unsigned x;
    volatile LAS unsigned* st;
};

__device__ __forceinline__ XcdBarrier xcd_barrier_post(unsigned* bar, volatile LAS unsigned* st) {
    XcdBarrier b; b.bar = bar; b.x = xb_xcc_id(); b.st = st;
    if (threadIdx.x == 0) (void)xb_add(&bar[XB_XCNT(b.x)], 1u);
    return b;
}
__device__ __forceinline__ void xcd_barrier_complete(unsigned* bar, unsigned x, unsigned& nloc, unsigned& nx) {
    const unsigned G = gridDim.x * gridDim.y * gridDim.z;
    unsigned sum, cnt, mine, sp = 0u;
    for (;;) {
        sum = 0u; cnt = 0u; mine = 0u;
#pragma unroll
        for (unsigned j = 0; j < 16; ++j) { const unsigned c = xb_ld(&bar[XB_XCNT(j)]); sum += c; cnt += (c > 0u) ? 1u : 0u; mine = (j == x) ? c : mine; }
        if (sum == G) break;
        __builtin_amdgcn_s_sleep(1);
        if ((++sp & 255u) == 0u) { if (xb_ld(&bar[XB_TMO])) break; if (sp > XB_SPIN_CAP) { atomicAdd(&bar[XB_TMO], 1u); break; } }
    }
    nloc = mine > 0u ? mine : 1u; nx = cnt > 0u ? cnt : 1u;
}

__device__ __forceinline__ void xcd_barrier(const XcdBarrier& b) {
    asm volatile("s_waitcnt vmcnt(0)" ::: "memory");
    __syncthreads();
    if (threadIdx.x == 0) {
        unsigned* bar = b.bar;
        __builtin_amdgcn_s_waitcnt(0);
        unsigned nloc = b.st[0], nx = b.st[1];
        if (nloc == 0u) { xcd_barrier_complete(bar, b.x, nloc, nx); b.st[0] = nloc; b.st[1] = nx; }
        const unsigned old = xb_add(&bar[XB_XSUB(b.x)], 1u);
        const unsigned gen = old / nloc;
        if (old + 1u == (gen + 1u) * nloc) {
            __builtin_amdgcn_fence(__ATOMIC_RELEASE, "agent");
            asm volatile("s_waitcnt vmcnt(0)" ::: "memory");
            const unsigned og = xb_add(&bar[XB_TOP], 1u);
            const unsigned tg = og / nx;
            if (og + 1u == (tg + 1u) * nx) xb_add(&bar[XB_TOPGEN], 1u);
            else XB_SPIN(xb_ld(&bar[XB_TOPGEN]) == tg, bar);
            __builtin_amdgcn_fence(__ATOMIC_ACQUIRE, "agent");
            xb_add(&bar[XB_XGEN(b.x)], 1u);
            asm volatile("s_waitcnt vmcnt(0)" ::: "memory");
        } else {
            XB_SPIN(xb_ld(&bar[XB_XGEN(b.x)]) == gen, bar);
            __builtin_amdgcn_fence(__ATOMIC_ACQUIRE, "agent");
            asm volatile("s_waitcnt vmcnt(0)" ::: "memory");
        }
    }
    __syncthreads();
}

struct Args { const float* in[30]; float* out; unsigned char* ws; int ph_lo, ph_hi; };
struct Ctx { LAS unsigned char* lds; int tid, lane, wave, bid, G, gw, NGW; };

DI float c448(float x) { return __builtin_amdgcn_fmed3f(x, -448.f, 448.f); }
DI void p0_transpose_item(const float* W, int K, int N, bf16* WT, int pad_from, int pad_rows, LAS float* scr, int item, int lane, float qs = 0.f) {
    const int nblk = N / 64, kb = item / nblk, nb = item % nblk, k0 = 64 * kb, n0 = 64 * nb;
    const int row_off = (n0 >= pad_from) ? pad_rows : 0;
    const int kr = lane >> 4, n4 = (lane & 15) * 4;
    f32x4 v[16];
#pragma unroll
    for (int i = 0; i < 16; ++i) v[i] = *(const f32x4*)(W + (size_t)(k0 + 4 * i + kr) * N + n0 + n4);
#pragma unroll
    for (int i = 0; i < 16; ++i) { LAS float* d = scr + (4 * i + kr) * 65 + n4; d[0] = v[i].x; d[1] = v[i].y; d[2] = v[i].z; d[3] = v[i].w; }
    LDS_WAIT(); asm volatile("" ::: "memory");
    const int kc = lane & 7, nr = lane >> 3;
#pragma unroll
    for (int j = 0; j < 8; ++j) { const int n = nr + 8 * j; const LAS float* sp = scr + (8 * kc) * 65 + n;
        if (qs != 0.f) { int t0 = 0, t1 = 0;
            t0 = __builtin_amdgcn_cvt_pk_fp8_f32(c448(sp[0 * 65] * qs), c448(sp[1 * 65] * qs), t0, false); t0 = __builtin_amdgcn_cvt_pk_fp8_f32(c448(sp[2 * 65] * qs), c448(sp[3 * 65] * qs), t0, true);
            t1 = __builtin_amdgcn_cvt_pk_fp8_f32(c448(sp[4 * 65] * qs), c448(sp[5 * 65] * qs), t1, false); t1 = __builtin_amdgcn_cvt_pk_fp8_f32(c448(sp[6 * 65] * qs), c448(sp[7 * 65] * qs), t1, true);
            v2u o; o.x = (unsigned)t0; o.y = (unsigned)t1;
            *(GAS v2u*)((unsigned char*)WT + (size_t)(row_off + n0 + n) * K + k0 + 8 * kc) = o; }
        else {
        v4u o; o.x = pk2(sp[0 * 65], sp[1 * 65]); o.y = pk2(sp[2 * 65], sp[3 * 65]); o.z = pk2(sp[4 * 65], sp[5 * 65]); o.w = pk2(sp[6 * 65], sp[7 * 65]);
        *(GAS v4u*)(WT + (size_t)(row_off + n0 + n) * K + k0 + 8 * kc) = o; } }
    LDS_WAIT(); asm volatile("" ::: "memory");
}
DI void phase_prologue(const Args& a, const Ctx& c) {
    unsigned char* ws = a.ws;
    {
        LAS float* scr = (LAS float*)(c.lds + c.wave * 16640);
        constexpr int I_IN = 32 * 170, I_A = 16 * 32, I_O = 32 * 32;
        for (int it = c.gw; it < I_IN + 2 * I_A + I_O; it += c.NGW) {
            int r = it;
            if (r < I_IN) { p0_transpose_item(a.in[6], 2048, 10880, (bf16*)(ws + WS_WIN), 6784, 128, scr, r, c.lane, 1024.f); continue; } r -= I_IN;
            if (r < I_A) { p0_transpose_item(a.in[22], 1024, 2048, (bf16*)(ws + WS_WA), 1 << 30, 0, scr, r, c.lane, 512.f); continue; } r -= I_A;
            if (r < I_A) { p0_transpose_item(a.in[23], 1024, 2048, (bf16*)(ws + WS_WB), 1 << 30, 0, scr, r, c.lane, 512.f); continue; } r -= I_A;
            p0_transpose_item(a.in[24], 2048, 2048, (bf16*)(ws + WS_WOUT), 1 << 30, 0, scr, r, c.lane, 1024.f);
        }
    }
    const int gt = c.bid * 512 + c.tid, NGT = c.G * 512;
    for (int i = gt; i < 128 * 2048 / 16; i += NGT) *(GAS v4u*)(ws + WS_WIN + (size_t)6784 * 2048 + (size_t)i * 16) = (v4u){0u, 0u, 0u, 0u};
    for (int ch = gt; ch < 5 * 1024 * 32; ch += NGT) {
        const int g = ch >> 15, n = (ch >> 5) & 1023, k0 = (ch & 31) * 8;
        float v[8];
#pragma unroll
        for (int e = 0; e < 8; ++e) { const int k = k0 + e; float x = 0.f;
            if (g < 2) { if (k < 96) x = a.in[13][(size_t)(g * 96 + k) * 1024 + n]; }
            else if (g < 4) { if (k < 96) x = a.in[15][(size_t)((g - 2) * 96 + k) * 1024 + n]; }
            else x = a.in[16][(size_t)k * 1024 + n];
            v[e] = x; }
        v4u o; o.x = pk2(v[0], v[1]); o.y = pk2(v[2], v[3]); o.z = pk2(v[4], v[5]); o.w = pk2(v[6], v[7]);
        *(GAS v4u*)((bf16*)(ws + WS_LORA) + (size_t)g * 1024 * 256 + (size_t)n * 256 + k0) = o;
    }
    __syncthreads();
    {
        LAS float* subl = (LAS float*)c.lds;
        LAS float* wql = (LAS float*)(c.lds + 66048);
        const int n = c.tid & 127, mg = c.tid >> 7;
        int cur_half = -1;
        for (int item = c.bid; item < 1024; item += c.G) {
            const int seg = item >> 6, mblk = item & 63, half = seg & 1;
            if (half != cur_half) {
                __syncthreads();
                const float* sub = half ? a.in[27] : a.in[26];
                for (int i = 0; i < 32; ++i) { const int idx = c.tid + 512 * i; subl[(idx >> 7) * 129 + (idx & 127)] = sub[idx]; }
                cur_half = half;
            }
            for (int i = 0; i < 8; ++i) { const int idx = c.tid + 512 * i; wql[idx] = a.in[25][(size_t)(mblk * 32 + (idx >> 7)) * 2048 + seg * 128 + (idx & 127)]; }
            __syncthreads();
            float acc[8];
#pragma unroll
            for (int j = 0; j < 8; ++j) acc[j] = 0.f;
            for (int d = 0; d < 128; d += 4) {
                const float s0 = subl[n * 129 + d], s1 = subl[n * 129 + d + 1], s2 = subl[n * 129 + d + 2], s3 = subl[n * 129 + d + 3];
#pragma unroll
                for (int j = 0; j < 8; ++j) { const f32x4 w = *(const LAS f32x4*)(wql + (mg * 8 + j) * 128 + d); acc[j] += s0 * w.x + s1 * w.y + s2 * w.z + s3 * w.w; }
            }
            v4u o; o.x = pk2(acc[0], acc[1]); o.y = pk2(acc[2], acc[3]); o.z = pk2(acc[4], acc[5]); o.w = pk2(acc[6], acc[7]);
            *(GAS v4u*)((bf16*)(ws + WS_WQS) + (size_t)(seg * 128 + n) * 2048 + mblk * 32 + mg * 8) = o;
            __syncthreads();
        }
    }
    {
        float* mod = (float*)(ws + WS_MOD);
        LAS float* red = (LAS float*)c.lds;
        const int c4 = c.tid & 15, kg = c.tid >> 4;
        for (int sl = c.bid; sl < 192; sl += c.G) {
            const float* wp = a.in[2] + sl * 64 + c4 * 4;
            f32x4 a0 = (f32x4){0.f, 0.f, 0.f, 0.f}, a1 = a0;
#pragma unroll 8
            for (int i = 0; i < 64; ++i) { const int k = kg + 32 * i;
                const float c0 = a.in[1][k], c1 = a.in[1][2048 + k];
                const float s0 = c0 * sigm(c0), s1 = c1 * sigm(c1);
                const f32x4 w = *(const f32x4*)(wp + (size_t)k * 12288);
                a0 += w * s0; a1 += w * s1; }
            __syncthreads();
            *(LAS f32x4*)(red + (kg * 16 + c4) * 8) = a0; *(LAS f32x4*)(red + (kg * 16 + c4) * 8 + 4) = a1;
            __syncthreads();
            if (c.tid < 128) { const int q = c.tid >> 3, j = c.tid & 7; float sum = 0.f;
                for (int g = 0; g < 32; ++g) sum += red[(g * 16 + q) * 8 + j];
                const int col = sl * 64 + q * 4 + (j & 3);
                mod[(size_t)(j >> 2) * 12288 + col] = sum + a.in[3][col]; }
            __syncthreads();
        }
    }
}

template <bool Q8> DI void phase_norm_mod(const Ctx& c, const float* x, const float* nw, const float* mod, int shift_off, int scale_off, bf16* dst) {
    for (int rp = c.gw; rp < MROWS / 2; rp += c.NGW) {
        const int b = (2 * rp) >> 13;
        f32x4 v[2][8]; float ss[2];
#pragma unroll
        for (int z = 0; z < 2; ++z) { const f32x4* xr = (const f32x4*)(x + (size_t)(2 * rp + z) * DM) + c.lane;
#pragma unroll
            for (int j = 0; j < 8; ++j) v[z][j] = xr[64 * j]; }
#pragma unroll
        for (int z = 0; z < 2; ++z) { float q = 0.f;
#pragma unroll
            for (int j = 0; j < 8; ++j) q += (v[z][j].x * v[z][j].x + v[z][j].y * v[z][j].y) + (v[z][j].z * v[z][j].z + v[z][j].w * v[z][j].w);
            ss[z] = rsqrtf(wave_sum_fast(q) * (1.0f / DM) + 1e-6f); }
        const f32x4* wv = (const f32x4*)nw + c.lane;
        const f32x4* sh = (const f32x4*)(mod + (size_t)b * 12288 + shift_off) + c.lane;
        const f32x4* sc = (const f32x4*)(mod + (size_t)b * 12288 + scale_off) + c.lane;
#pragma unroll
        for (int j = 0; j < 8; ++j) { const f32x4 w = wv[64 * j], s = sh[64 * j], g = sc[64 * j];
#pragma unroll
            for (int z = 0; z < 2; ++z) { const f32x4 y = (v[z][j] * ss[z]) * w * (g + 1.0f) + s;
                if (Q8) { int t = 0; t = __builtin_amdgcn_cvt_pk_fp8_f32(c448(y.x * 8.f), c448(y.y * 8.f), t, false); t = __builtin_amdgcn_cvt_pk_fp8_f32(c448(y.z * 8.f), c448(y.w * 8.f), t, true);
                    ((unsigned*)((unsigned char*)dst + (size_t)(2 * rp + z) * DM) + c.lane)[64 * j] = (unsigned)t; }
                else { v2u p; p.x = pk2(y.x, y.y); p.y = pk2(y.z, y.w); ((v2u*)(dst + (size_t)(2 * rp + z) * DM) + c.lane)[64 * j] = p; } } }
    }
}

DI void phase_qknorm_prep(const Args& a, const Ctx& c) {
    unsigned char* ws = a.ws;
    bf16* ZA = (bf16*)(ws + WS_ZA); const bf16* ZB = (const bf16*)(ws + WS_ZB);
    bf16* R16 = (bf16*)(ws + WS_R); bf16* K16 = (bf16*)(ws + WS_K); bf16* V16 = (bf16*)(ws + WS_V); bf16* KK16 = (bf16*)(ws + WS_KK);
    bf16* T = (bf16*)(ws + WS_T);
    const float* mu0 = a.in[11]; const float* mu1 = a.in[11] + 3712;
    for (int row = c.gw; row < MROWS; row += c.NGW) {
        {
            bf16* zr = ZA + (size_t)row * 3072;
#pragma unroll
            for (int cc = 0; cc < 4; ++cc) {
                const int col = cc * 512 + c.lane * 8;
                const v4u u = *(const v4u*)(zr + col);
                float v[8] = {bflo(u.x), bfhi(u.x), bflo(u.y), bfhi(u.y), bflo(u.z), bfhi(u.z), bflo(u.w), bfhi(u.w)};
                float ss = 0.f;
#pragma unroll
                for (int e = 0; e < 8; ++e) ss += v[e] * v[e];
                ss += __shfl_xor(ss, 1); ss += __shfl_xor(ss, 2); ss += __shfl_xor(ss, 4); ss += __shfl_xor(ss, 8);
                const bool isq = cc < 2;
                const float rstd = rsqrtf(ss * (1.0f / 128.0f) + 1e-6f) * (isq ? 0.08838834764831845f : 1.0f);
                const float* wn = (isq ? a.in[8] : a.in[9]) + (c.lane & 15) * 8;
#pragma unroll
                for (int e = 0; e < 8; ++e) v[e] = v[e] * rstd * wn[e];
                v4u o; o.x = pk2(v[0], v[1]); o.y = pk2(v[2], v[3]); o.z = pk2(v[4], v[5]); o.w = pk2(v[6], v[7]);
                *(v4u*)(zr + col) = o;
            }
        }
        {
            const int t = row & (SEQ - 1);
            const bool hp = t > 0, hn = t < SEQ - 1;
            const bf16* zc = ZB + (size_t)row * 3840;
#pragma unroll
            for (int p = 0; p < 8; ++p) {
                const int ch = c.lane + 64 * p;
                const bool act = (p < 7) || (c.lane < 16);
                const int col = act ? ch * 8 : 0;
                const v4u uc = *(const v4u*)(zc + col);
                v4u up = (v4u){0u, 0u, 0u, 0u}, un = up;
                if (hp) up = *(const v4u*)(zc - 3840 + col);
                if (hn) un = *(const v4u*)(zc + 3840 + col);
                const f32x4 m0a = *(const f32x4*)(mu0 + col), m0b = *(const f32x4*)(mu0 + col + 4), m1a = *(const f32x4*)(mu1 + col), m1b = *(const f32x4*)(mu1 + col + 4);
                const float yc[8] = {bflo(uc.x), bfhi(uc.x), bflo(uc.y), bfhi(uc.y), bflo(uc.z), bfhi(uc.z), bflo(uc.w), bfhi(uc.w)};
                const float yp[8] = {bflo(up.x), bfhi(up.x), bflo(up.y), bfhi(up.y), bflo(up.z), bfhi(up.z), bflo(up.w), bfhi(up.w)};
                const float yn[8] = {bflo(un.x), bfhi(un.x), bflo(un.y), bfhi(un.y), bflo(un.z), bfhi(un.z), bflo(un.w), bfhi(un.w)};
                const float m0[8] = {m0a.x, m0a.y, m0a.z, m0a.w, m0b.x, m0b.y, m0b.z, m0b.w};
                const float m1[8] = {m1a.x, m1a.y, m1a.z, m1a.w, m1b.x, m1b.y, m1b.z, m1b.w};
                float zs[8];
#pragma unroll
                for (int e = 0; e < 8; ++e) zs[e] = yc[e] + m0[e] * (yp[e] - yc[e]) + m1[e] * (yn[e] - yc[e]);
                if (p < 2) {
                    v4u o; o.x = pk2(zs[0], zs[1]); o.y = pk2(zs[2], zs[3]); o.z = pk2(zs[4], zs[5]); o.w = pk2(zs[6], zs[7]);
                    *(v4u*)(R16 + (size_t)row * 1024 + col) = o;
                } else if (p < 4) {
                    const int kc = col - 1024;
                    v4u o; o.x = pk2(zs[0], zs[1]); o.y = pk2(zs[2], zs[3]); o.z = pk2(zs[4], zs[5]); o.w = pk2(zs[6], zs[7]);
                    *(v4u*)(K16 + (size_t)row * 1024 + kc) = o;
                    const f32x4 ka = *(const f32x4*)(a.in[17] + kc), kb = *(const f32x4*)(a.in[17] + kc + 4);
                    float kx[8] = {zs[0] * ka.x, zs[1] * ka.y, zs[2] * ka.z, zs[3] * ka.w, zs[4] * kb.x, zs[5] * kb.y, zs[6] * kb.z, zs[7] * kb.w};
                    float ss = 0.f;
#pragma unroll
                    for (int e = 0; e < 8; ++e) ss += kx[e] * kx[e];
                    ss += __shfl_xor(ss, 1); ss += __shfl_xor(ss, 2); ss += __shfl_xor(ss, 4);
                    const float inv = 1.0f / fmaxf(sqrtf(ss), 1e-12f);
                    v4u q; q.x = pk2(kx[0] * inv, kx[1] * inv); q.y = pk2(kx[2] * inv, kx[3] * inv); q.z = pk2(kx[4] * inv, kx[5] * inv); q.w = pk2(kx[6] * inv, kx[7] * inv);
                    *(v4u*)(KK16 + (size_t)row * 1024 + kc) = q;
                } else if (p < 6) {
                    v4u o; o.x = pk2(zs[0], zs[1]); o.y = pk2(zs[2], zs[3]); o.z = pk2(zs[4], zs[5]); o.w = pk2(zs[6], zs[7]);
                    *(v4u*)(V16 + (size_t)row * 1024 + (col - 2048)) = o;
                } else if (act) {
                    const int off = col - 3072;
                    int buf, k;
                    if (off < 96) { buf = 0; k = off; } else if (off < 192) { buf = 1; k = off - 96; } else if (off < 288) { buf = 2; k = off - 192; } else if (off < 384) { buf = 3; k = off - 288; } else { buf = 4; k = off - 384; }
                    float y[8];
#pragma unroll
                    for (int e = 0; e < 8; ++e) y[e] = (buf < 2) ? tanhf(zs[e]) : ((buf == 4) ? sigm(zs[e]) : zs[e]);
                    v4u o; o.x = pk2(y[0], y[1]); o.y = pk2(y[2], y[3]); o.z = pk2(y[4], y[5]); o.w = pk2(y[6], y[7]);
                    *(v4u*)(T + (size_t)buf * MROWS * 256 + (size_t)row * 256 + k) = o;
                }
            }
            for (int i = c.lane; i < 80; i += 64) { const int buf = i / 20, chk = 12 + i % 20;
                *(v4u*)(T + (size_t)buf * MROWS * 256 + (size_t)row * 256 + chk * 8) = (v4u){0u, 0u, 0u, 0u}; }
        }
    }
}

DI void phase_vtranspose(const Args& a, const Ctx& c) {
    const bf16* ZA = (const bf16*)(a.ws + WS_ZA); bf16* VT = (bf16*)(a.ws + WS_VT);
    LAS bf16* tile = (LAS bf16*)(c.lds + c.wave * 9216);
    for (int item = c.gw; item < 256 * 16; item += c.NGW) {
        const int t0 = (item >> 4) * 64, c0 = (item & 15) * 64;
#pragma unroll
        for (int ch = 0; ch < 8; ++ch) *(LAS v4u*)(tile + c.lane * 72 + 8 * ch) = *(const v4u*)(ZA + (size_t)(t0 + c.lane) * 3072 + 2048 + c0 + 8 * ch);
        LDS_WAIT(); asm volatile("" ::: "memory");
        const int cg = c0 + c.lane, b = t0 >> 13, pos0 = t0 & (SEQ - 1);
        bf16* dst = VT + ((size_t)(b * 8 + (cg >> 7)) * 128 + (cg & 127)) * SEQ + pos0;
#pragma unroll
        for (int j = 0; j < 8; ++j) { unsigned e[8];
#pragma unroll
            for (int q = 0; q < 8; ++q) e[q] = tile[(8 * j + q) * 72 + c.lane];
            v4u o; o.x = e[0] | (e[1] << 16); o.y = e[2] | (e[3] << 16); o.z = e[4] | (e[5] << 16); o.w = e[6] | (e[7] << 16);
            *(v4u*)(dst + 8 * j) = o; }
        LDS_WAIT(); asm volatile("" ::: "memory");
    }
}

typedef short bf16x8 __attribute__((ext_vector_type(8)));
struct NaTask { int b, h, i, cq; };
DI void na_part_a(const bf16* ZA, const LAS float* rpbl, int lane, const NaTask t, int half, f32x4 (&S)[8][2], bf16x8 (&pf)[8], float& inv) {
    const int l15 = lane & 15, q4 = lane >> 4, b = t.b, h = t.h, i = t.i, cq = t.cq;
    const int wsc = min(max(16 * cq - 8, 0), 32);
    const int jq = 16 * cq + l15, cs = min(max(jq - 8, 0), 48);
    const int rs = min(max(i - 4, 0), 120);
    const size_t qtok = (size_t)b * SEQ + i * 64 + jq;
    bf16x8 qf[4];
#pragma unroll
    for (int ks = 0; ks < 4; ++ks) qf[ks] = *(const bf16x8*)(ZA + qtok * 3072 + h * 128 + 32 * ks + 8 * q4);
#pragma unroll
    for (int rh = 0; rh < 4; ++rh) {
        if ((rh >> 1) == half) {
        bf16x8 kf[4][4];
#pragma unroll
        for (int tt = 0; tt < 4; ++tt) { const int r = 2 * rh + (tt >> 1), u = tt & 1;
            const int kcol = wsc + 8 * (l15 >> 2) + 4 * u + (l15 & 3);
            const bf16* kp = ZA + ((size_t)b * SEQ + (rs + r) * 64 + kcol) * 3072 + 1024 + h * 128 + 8 * q4;
#pragma unroll
            for (int ks = 0; ks < 4; ++ks) kf[tt][ks] = *(const bf16x8*)(kp + 32 * ks); }
        __builtin_amdgcn_sched_barrier(0);
#pragma unroll
        for (int tt = 0; tt < 4; ++tt) { f32x4 acc = (f32x4){0.f, 0.f, 0.f, 0.f};
#pragma unroll
            for (int ks = 0; ks < 4; ++ks) acc = __builtin_amdgcn_mfma_f32_16x16x32_bf16(kf[tt][ks], qf[ks], acc, 0, 0, 0);
            S[2 * rh + (tt >> 1)][tt & 1] = acc; }
        }
    }
    if (half == 0) return;
    float mx = -1e30f;
#pragma unroll
    for (int r = 0; r < 8; ++r)
#pragma unroll
        for (int u = 0; u < 2; ++u)
#pragma unroll
            for (int j = 0; j < 4; ++j) {
                const int kc = wsc + 8 * q4 + 4 * u + j;
                const bool valid = (kc >= cs) && (kc < cs + 16);
                const int bi = valid ? ((rs + r - i + 7) * 31 + (kc - jq + 15)) : 0;
                const float sv = valid ? (S[r][u][j] + rpbl[bi]) : -1e30f;
                S[r][u][j] = sv; mx = fmaxf(mx, sv);
            }
    mx = fmaxf(mx, __shfl_xor(mx, 16)); mx = fmaxf(mx, __shfl_xor(mx, 32));
    float sum = 0.f;
#pragma unroll
    for (int r = 0; r < 8; ++r)
#pragma unroll
        for (int u = 0; u < 2; ++u)
#pragma unroll
            for (int j = 0; j < 4; ++j) { const float p = __expf(S[r][u][j] - mx); S[r][u][j] = p; sum += p; }
    sum += __shfl_xor(sum, 16); sum += __shfl_xor(sum, 32);
    inv = 1.0f / sum;
#pragma unroll
    for (int r = 0; r < 8; ++r) { v4u w; w.x = pk2(S[r][0][0], S[r][0][1]); w.y = pk2(S[r][0][2], S[r][0][3]); w.z = pk2(S[r][1][0], S[r][1][1]); w.w = pk2(S[r][1][2], S[r][1][3]);
        pf[r] = __builtin_bit_cast(bf16x8, w); }
}
DI void na_part_b(const bf16* VT, bf16* OA, int lane, const NaTask t, int half, const bf16x8 (&pf)[8], float inv) {
    const int l15 = lane & 15, q4 = lane >> 4, b = t.b, h = t.h, i = t.i, cq = t.cq;
    const int wsc = min(max(16 * cq - 8, 0), 32);
    const int rs = min(max(i - 4, 0), 120);
    const size_t qtok = (size_t)b * SEQ + i * 64 + 16 * cq + l15;
#pragma unroll
    for (int dh = 0; dh < 4; ++dh) {
        if ((dh >> 1) == half) {
        bf16x8 vf[2][8];
#pragma unroll
        for (int d4 = 0; d4 < 2; ++d4) { const int dt = 2 * dh + d4;
            const bf16* vp = VT + ((size_t)(b * 8 + h) * 128 + 16 * dt + l15) * SEQ + rs * 64 + wsc + 8 * q4;
#pragma unroll
            for (int r = 0; r < 8; ++r) vf[d4][r] = *(const bf16x8*)(vp + r * 64); }
        __builtin_amdgcn_sched_barrier(0);
#pragma unroll
        for (int d4 = 0; d4 < 2; ++d4) { const int dt = 2 * dh + d4;
            f32x4 o = (f32x4){0.f, 0.f, 0.f, 0.f};
#pragma unroll
            for (int r = 0; r < 8; ++r) o = __builtin_amdgcn_mfma_f32_16x16x32_bf16(vf[d4][r], pf[r], o, 0, 0, 0);
            const float i16 = inv * 16.f; int w = 0; w = __builtin_amdgcn_cvt_pk_fp8_f32(c448(o[0] * i16), c448(o[1] * i16), w, false); w = __builtin_amdgcn_cvt_pk_fp8_f32(c448(o[2] * i16), c448(o[3] * i16), w, true);
            *(int*)((unsigned char*)OA + qtok * 1024 + h * 128 + 16 * dt + 4 * q4) = w; }
        }
    }
}

DI void phase_na_attention(const Args& a, const Ctx& c) {
    const bf16* ZA = (const bf16*)(a.ws + WS_ZA); const bf16* VT = (const bf16*)(a.ws + WS_VT); bf16* OA = (bf16*)(a.ws + WS_OA);
    LAS float* rpbl = (LAS float*)c.lds;
    for (int blk = c.bid; blk < 256; blk += c.G) {
        const int b = blk >> 7, h = (blk >> 4) & 7, i0 = ((blk & 15) * 2 + 1) * 4;
        __syncthreads();
        for (int t = c.tid; t < 465; t += 512) rpbl[t] = a.in[10][h * 465 + t];
        __syncthreads();
        const int l15 = c.lane & 15, q4 = c.lane >> 4, cq = c.wave & 3;
        const int wsc = min(max(16 * cq - 8, 0), 32);
        const int jq = 16 * cq + l15, cs = min(max(jq - 8, 0), 48);
#pragma unroll 1
        for (int k = 0; k < 2; ++k) {
            const int i = i0 + 2 * k + (c.wave >> 2);
            const int rs = min(max(i - 4, 0), 120);
            const size_t qtok = (size_t)b * SEQ + i * 64 + jq;
            bf16x8 qf[4];
#pragma unroll
            for (int ks = 0; ks < 4; ++ks) qf[ks] = *(const bf16x8*)(ZA + qtok * 3072 + h * 128 + 32 * ks + 8 * q4);
            f32x4 S[8][2];
#pragma unroll
            for (int rh = 0; rh < 2; ++rh) {
                bf16x8 kf[8][4];
#pragma unroll
                for (int t = 0; t < 8; ++t) { const int r = 4 * rh + (t >> 1), u = t & 1;
                    const int kcol = wsc + 8 * (l15 >> 2) + 4 * u + (l15 & 3);
                    const bf16* kp = ZA + ((size_t)b * SEQ + (rs + r) * 64 + kcol) * 3072 + 1024 + h * 128 + 8 * q4;
#pragma unroll
                    for (int ks = 0; ks < 4; ++ks) kf[t][ks] = *(const bf16x8*)(kp + 32 * ks); }
                __builtin_amdgcn_sched_barrier(0);
#pragma unroll
                for (int t = 0; t < 8; ++t) { f32x4 acc = (f32x4){0.f, 0.f, 0.f, 0.f};
#pragma unroll
                    for (int ks = 0; ks < 4; ++ks) acc = __builtin_amdgcn_mfma_f32_16x16x32_bf16(kf[t][ks], qf[ks], acc, 0, 0, 0);
                    S[4 * rh + (t >> 1)][t & 1] = acc; }
            }
            float mx = -1e30f;
#pragma unroll
            for (int r = 0; r < 8; ++r)
#pragma unroll
                for (int u = 0; u < 2; ++u)
#pragma unroll
                    for (int j = 0; j < 4; ++j) {
                        const int kc = wsc + 8 * q4 + 4 * u + j;
                        const bool valid = (kc >= cs) && (kc < cs + 16);
                        const int bi = valid ? ((rs + r - i + 7) * 31 + (kc - jq + 15)) : 0;
                        const float sv = valid ? (S[r][u][j] + rpbl[bi]) : -1e30f;
                        S[r][u][j] = sv; mx = fmaxf(mx, sv);
                    }
            mx = fmaxf(mx, __shfl_xor(mx, 16)); mx = fmaxf(mx, __shfl_xor(mx, 32));
            float sum = 0.f;
#pragma unroll
            for (int r = 0; r < 8; ++r)
#pragma unroll
                for (int u = 0; u < 2; ++u)
#pragma unroll
                    for (int j = 0; j < 4; ++j) { const float p = __expf(S[r][u][j] - mx); S[r][u][j] = p; sum += p; }
            sum += __shfl_xor(sum, 16); sum += __shfl_xor(sum, 32);
            const float inv = 1.0f / sum;
            bf16x8 pf[8];
#pragma unroll
            for (int r = 0; r < 8; ++r) { v4u w; w.x = pk2(S[r][0][0], S[r][0][1]); w.y = pk2(S[r][0][2], S[r][0][3]); w.z = pk2(S[r][1][0], S[r][1][1]); w.w = pk2(S[r][1][2], S[r][1][3]);
                pf[r] = __builtin_bit_cast(bf16x8, w); }
#pragma unroll
            for (int dh = 0; dh < 2; ++dh) {
                bf16x8 vf[4][8];
#pragma unroll
                for (int d4 = 0; d4 < 4; ++d4) { const int dt = 4 * dh + d4;
                    const bf16* vp = VT + ((size_t)(b * 8 + h) * 128 + 16 * dt + l15) * SEQ + rs * 64 + wsc + 8 * q4;
#pragma unroll
                    for (int r = 0; r < 8; ++r) vf[d4][r] = *(const bf16x8*)(vp + r * 64); }
                __builtin_amdgcn_sched_barrier(0);
#pragma unroll
                for (int d4 = 0; d4 < 4; ++d4) { const int dt = 4 * dh + d4;
                    f32x4 o = (f32x4){0.f, 0.f, 0.f, 0.f};
#pragma unroll
                    for (int r = 0; r < 8; ++r) o = __builtin_amdgcn_mfma_f32_16x16x32_bf16(vf[d4][r], pf[r], o, 0, 0, 0);
                    const float i16 = inv * 16.f; int w = 0; w = __builtin_amdgcn_cvt_pk_fp8_f32(c448(o[0] * i16), c448(o[1] * i16), w, false); w = __builtin_amdgcn_cvt_pk_fp8_f32(c448(o[2] * i16), c448(o[3] * i16), w, true);
                    *(int*)((unsigned char*)OA + qtok * 1024 + h * 128 + 16 * dt + 4 * q4) = w; }
            }
        }
    }
}

typedef short bf16x4 __attribute__((ext_vector_type(4)));
typedef __bf16 bf16x2_t __attribute__((ext_vector_type(2)));
DI unsigned cvtpk(float lo, float hi) { f32x2 v = {lo, hi}; bf16x2_t b = __builtin_convertvector(v, bf16x2_t); return __builtin_bit_cast(unsigned, b); }
DI f32x4 mfma32(bf16x8 a, bf16x8 b, f32x4 c) { return __builtin_amdgcn_mfma_f32_16x16x32_bf16(a, b, c, 0, 0, 0); }
DI f32x4 mfma16(bf16x4 a, bf16x4 b, f32x4 c) { return __builtin_amdgcn_mfma_f32_16x16x16bf16_1k(a, b, c, 0, 0, 0); }
DI bf16x4 pack4(f32x4 v) { v2u w; w.x = cvtpk(v[0], v[1]); w.y = cvtpk(v[2], v[3]); return __builtin_bit_cast(bf16x4, w); }
DI bf16x8 pack8(f32x4 a, f32x4 b) { v4u w; w.x = cvtpk(a[0], a[1]); w.y = cvtpk(a[2], a[3]); w.z = cvtpk(b[0], b[1]); w.w = cvtpk(b[2], b[3]); return __builtin_bit_cast(bf16x8, w); }
#define SC_BARRIER() do { asm volatile("s_waitcnt lgkmcnt(0)" ::: "memory"); __builtin_amdgcn_s_barrier(); asm volatile("" ::: "memory"); } while (0)
constexpr int SC_SLOT = 16384, SC_SCR = 131072, SC_SCRB = 6528, SC_ROW = 136;
DI void phase_scan(const Args& a, const Ctx& c) {
    unsigned char* ws = a.ws;
    const bf16* R16 = (const bf16*)(ws + WS_R); const bf16* K16 = (const bf16*)(ws + WS_K); const bf16* V16 = (const bf16*)(ws + WS_V); const bf16* KK16 = (const bf16*)(ws + WS_KK);
    const int lane = c.lane, l15 = lane & 15, kq = lane >> 4;
    const f32x4 Z4 = (f32x4){0.f, 0.f, 0.f, 0.f};
    for (int job = c.bid; job < 256; job += c.G) {
        const int p = job >> 2, sg = job & 3, cb = 128 * sg, dir = p >> 5, b = (p >> 4) & 1, h = p & 15;
        bf16* PHI = (bf16*)(ws + (dir ? WS_PHIB : WS_PHIF));
        LAS float* rpbl = (LAS float*)(c.lds + 157824);
        for (int t_ = c.tid; t_ < 465; t_ += 512) rpbl[t_] = a.in[10][(((job * 32) >> 9) & 7) * 465 + t_];
        const bf16* IC = (const bf16*)(ws + (dir ? WS_ICB : WS_ICF)); const bf16* LW = (const bf16*)(ws + (dir ? WS_LWB : WS_LWF));
        bf16* O = (bf16*)(ws + (dir ? WS_OBW : WS_OF));
        __syncthreads();
        if (c.wave >= 4) {
            const int pw = c.wave - 4;
            LAS unsigned char* scr = c.lds + SC_SCR + pw * SC_SCRB;
            float ka[2][8];
#pragma unroll
            for (int ks = 0; ks < 2; ++ks)
#pragma unroll
                for (int e = 0; e < 8; ++e) ka[ks][e] = a.in[18][h * 64 + 32 * ks + 16 * (e >> 2) + 4 * kq + (e & 3)];
#pragma unroll
            for (int ks = 0; ks < 2; ++ks)
#pragma unroll
                for (int e = 0; e < 8; ++e) asm volatile("" : "+v"(ka[ks][e]));
            v2u raw[6][4], rawN[6][4];
#define SC_LOAD(dst, cc) do { const int ng_ = 16 * (cb + (cc)) + l15, t_ = dir ? (SEQ - 1 - ng_) : ng_; const size_t o_ = (size_t)(b * SEQ + t_) * 1024 + h * 64 + 4 * kq; \
                _Pragma("unroll") for (int g_ = 0; g_ < 4; ++g_) { dst[0][g_] = *(const v2u*)(R16 + o_ + 16 * g_); dst[1][g_] = *(const v2u*)(K16 + o_ + 16 * g_); dst[2][g_] = *(const v2u*)(V16 + o_ + 16 * g_); \
                    dst[3][g_] = *(const v2u*)(KK16 + o_ + 16 * g_); dst[4][g_] = *(const v2u*)(IC + o_ + 16 * g_); dst[5][g_] = *(const v2u*)(LW + o_ + 16 * g_); } } while (0)
#define SC_FLUSH(sl, ch) do { const int n_ = lane >> 2, pt_ = lane & 3, ng_ = 16 * (cb + (ch)) + n_, t_ = dir ? (SEQ - 1 - ng_) : ng_; \
                const LAS v4u* s_ = (const LAS v4u*)((sl) + 9984 + pt_ * 1536 + 512 + n_ * 32); const v4u x0_ = s_[0], x1_ = s_[1], y0_ = s_[32], y1_ = s_[33]; \
                const size_t go_ = (size_t)(b * SEQ + t_) * 1024 + h * 64 + 16 * pt_; \
                v4u* d_ = (v4u*)(O + go_); d_[0] = x0_; d_[1] = x1_; \
                if (sg > 0) { v4u* e_ = (v4u*)(PHI + (size_t)(b * 6144 + ng_ - 2048) * 1024 + h * 64 + 16 * pt_); e_[0] = y0_; e_[1] = y1_; } } while (0)
            SC_LOAD(raw, pw); SC_LOAD(rawN, pw + 4);
#pragma unroll 1
            for (int it = -1; it < 34; ++it) {
                const int cc = 4 * (it + 1) + pw;
                if (cc >= 128 && cc < 136) { SC_FLUSH(c.lds + (((it + 1) & 1) * 4 + pw) * SC_SLOT, cc - 8); }
                if (cc < 128) {
                    LAS unsigned char* slot = c.lds + (((it + 1) & 1) * 4 + pw) * SC_SLOT;
                    if (cc >= 8) SC_FLUSH(slot, cc - 8);
                    f32x4 mab_b = Z4, mab_a = Z4, mak_a = Z4, mrb_a = Z4, mrk_a = Z4;
#pragma unroll
                    for (int ks = 0; ks < 2; ++ks) {
                        float r[8], k[8], v[8], kk[8], ic[8], lw[8];
#pragma unroll
                        for (int hf = 0; hf < 2; ++hf) { const int g = 2 * ks + hf;
                            r[4 * hf] = bflo(raw[0][g].x); r[4 * hf + 1] = bfhi(raw[0][g].x); r[4 * hf + 2] = bflo(raw[0][g].y); r[4 * hf + 3] = bfhi(raw[0][g].y);
                            k[4 * hf] = bflo(raw[1][g].x); k[4 * hf + 1] = bfhi(raw[1][g].x); k[4 * hf + 2] = bflo(raw[1][g].y); k[4 * hf + 3] = bfhi(raw[1][g].y);
                            v[4 * hf] = bflo(raw[2][g].x); v[4 * hf + 1] = bfhi(raw[2][g].x); v[4 * hf + 2] = bflo(raw[2][g].y); v[4 * hf + 3] = bfhi(raw[2][g].y);
                            kk[4 * hf] = bflo(raw[3][g].x); kk[4 * hf + 1] = bfhi(raw[3][g].x); kk[4 * hf + 2] = bflo(raw[3][g].y); kk[4 * hf + 3] = bfhi(raw[3][g].y);
                            ic[4 * hf] = bflo(raw[4][g].x); ic[4 * hf + 1] = bfhi(raw[4][g].x); ic[4 * hf + 2] = bflo(raw[4][g].y); ic[4 * hf + 3] = bfhi(raw[4][g].y);
                            lw[4 * hf] = bflo(raw[5][g].x); lw[4 * hf + 1] = bfhi(raw[5][g].x); lw[4 * hf + 2] = bflo(raw[5][g].y); lw[4 * hf + 3] = bfhi(raw[5][g].y); }
                        float cum[8], tot[8];
#pragma unroll
                        for (int e = 0; e < 8; ++e) cum[e] = lw[e];
#pragma unroll
                        for (int e = 0; e < 8; ++e) { tot[e] = row16_sum(lw[e]);
                            cum[e] += dpp_mov<0x111>(cum[e]); cum[e] += dpp_mov<0x112>(cum[e]); cum[e] += dpp_mov<0x114>(cum[e]); cum[e] += dpp_mov<0x118>(cum[e]); }
                        float at[8], bh[8], kh[8], rt[8], bbv[8], kbv[8], gam[8];
#pragma unroll
                        for (int e = 0; e < 8; ++e) gam[e] = __expf(tot[e]);
#pragma unroll
                        for (int e = 0; e < 8; ++e) {
                            const float bb = kk[e] * ic[e], kd = k[e] * (1.0f + (ic[e] - 1.0f) * ka[ks][e]);
                            const float ep = __expf(cum[e]), en = __builtin_amdgcn_rcpf(ep), ex = ep * __expf(-lw[e]), et = gam[e] * en;
                            at[e] = -kk[e] * ex; bh[e] = bb * en; kh[e] = kd * en; rt[e] = r[e] * ep; bbv[e] = bb * et; kbv[e] = kd * et;
                        }
                        v4u w;
                        w.x = cvtpk(at[0], at[1]); w.y = cvtpk(at[2], at[3]); w.z = cvtpk(at[4], at[5]); w.w = cvtpk(at[6], at[7]); const bf16x8 at_f = __builtin_bit_cast(bf16x8, w);
                        w.x = cvtpk(bh[0], bh[1]); w.y = cvtpk(bh[2], bh[3]); w.z = cvtpk(bh[4], bh[5]); w.w = cvtpk(bh[6], bh[7]); const bf16x8 bh_f = __builtin_bit_cast(bf16x8, w);
                        w.x = cvtpk(kh[0], kh[1]); w.y = cvtpk(kh[2], kh[3]); w.z = cvtpk(kh[4], kh[5]); w.w = cvtpk(kh[6], kh[7]); const bf16x8 kh_f = __builtin_bit_cast(bf16x8, w);
                        w.x = cvtpk(rt[0], rt[1]); w.y = cvtpk(rt[2], rt[3]); w.z = cvtpk(rt[4], rt[5]); w.w = cvtpk(rt[6], rt[7]); const bf16x8 rt_f = __builtin_bit_cast(bf16x8, w);
                        *(LAS bf16x8*)(slot + ks * 1024 + lane * 16) = at_f;
                        *(LAS bf16x8*)(slot + 2048 + ks * 1024 + lane * 16) = rt_f;
                        mab_b = mfma32(at_f, bh_f, mab_b); mab_a = mfma32(bh_f, at_f, mab_a); mak_a = mfma32(kh_f, at_f, mak_a); mrb_a = mfma32(bh_f, rt_f, mrb_a); mrk_a = mfma32(kh_f, rt_f, mrk_a);
#pragma unroll
                        for (int hf = 0; hf < 2; ++hf) { const int chb = (32 * ks + 16 * hf + 4 * kq) * 2;
                            v2u q; q.x = cvtpk(bbv[4 * hf], bbv[4 * hf + 1]); q.y = cvtpk(bbv[4 * hf + 2], bbv[4 * hf + 3]); *(LAS v2u*)(scr + l15 * SC_ROW + chb) = q;
                            q.x = cvtpk(kbv[4 * hf], kbv[4 * hf + 1]); q.y = cvtpk(kbv[4 * hf + 2], kbv[4 * hf + 3]); *(LAS v2u*)(scr + 2176 + l15 * SC_ROW + chb) = q;
                            *(LAS v2u*)(scr + 4352 + l15 * SC_ROW + chb) = raw[2][2 * ks + hf]; }
                        if (l15 == 0) {
#pragma unroll
                            for (int e = 0; e < 8; ++e) *(LAS float*)(slot + 9728 + 4 * (32 * ks + 16 * (e >> 2) + 4 * kq + (e & 3))) = gam[e]; }
                    }
                    f32x4 idm;
#pragma unroll
                    for (int rg = 0; rg < 4; ++rg) { const int m = 4 * kq + rg;
                        if (!(m < l15)) { mab_a[rg] = 0.f; mak_a[rg] = 0.f; }
                        if (!(m <= l15)) { mrb_a[rg] = 0.f; mrk_a[rg] = 0.f; }
                        if (!(l15 < m)) mab_b[rg] = 0.f;
                        idm[rg] = (m == l15) ? 1.0f : 0.0f; }
                    const bf16x4 Ma = pack4(mab_a), Mb = pack4(mab_b);
                    const f32x4 m2b = mfma16(Ma, Mb, Z4), m2a = mfma16(Mb, Ma, Z4);
                    const bf16x4 M2a = pack4(m2a), M2b = pack4(m2b);
                    const f32x4 m4b = mfma16(M2a, M2b, Z4), m4a = mfma16(M2b, M2a, Z4);
                    const bf16x4 M4a = pack4(m4a), M4b = pack4(m4b);
                    const f32x4 m8b = mfma16(M4a, M4b, Z4);
                    const f32x4 q1a = mfma16(pack4(m2b + idm), pack4(mab_a + idm), Z4);
                    const f32x4 q2a = mfma16(pack4(m4b + idm), pack4(q1a), Z4);
                    const f32x4 ta = mfma16(pack4(m8b + idm), pack4(q2a), Z4);
                    *(LAS bf16x4*)(slot + 8192 + lane * 8) = pack4(ta);
                    *(LAS bf16x4*)(slot + 8704 + lane * 8) = pack4(mrb_a);
                    *(LAS bf16x4*)(slot + 9216 + lane * 8) = pack4(mrk_a);
                    const bf16x4 Mak = pack4(mak_a);
                    LDS_WAIT(); asm volatile("" ::: "memory");
#pragma unroll
                    for (int jt = 0; jt < 4; ++jt) {
                        unsigned e0[4], e1[4], e2[4];
#pragma unroll
                        for (int e = 0; e < 4; ++e) { const int o = (4 * kq + e) * SC_ROW + (16 * jt + l15) * 2;
                            e0[e] = *(const LAS unsigned short*)(scr + o); e1[e] = *(const LAS unsigned short*)(scr + 2176 + o); e2[e] = *(const LAS unsigned short*)(scr + 4352 + o); }
                        v4u bk; bk.x = e0[0] | (e0[1] << 16); bk.y = e0[2] | (e0[3] << 16); bk.z = e1[0] | (e1[1] << 16); bk.w = e1[2] | (e1[3] << 16);
                        *(LAS v4u*)(slot + 4096 + jt * 1024 + lane * 16) = bk;
                        v2u vf; vf.x = e2[0] | (e2[1] << 16); vf.y = e2[2] | (e2[3] << 16);
                        *(LAS v2u*)(slot + 9984 + jt * 1536 + lane * 8) = vf;
                        const f32x4 w2 = mfma16(Mak, __builtin_bit_cast(bf16x4, vf), Z4);
                        *(LAS f32x4*)(slot + 9984 + jt * 1536 + 512 + lane * 16) = w2;
                    }
                    LDS_WAIT(); asm volatile("" ::: "memory");
                }
#pragma unroll
                for (int i = 0; i < 6; ++i)
#pragma unroll
                    for (int g = 0; g < 4; ++g) raw[i][g] = rawN[i][g];
                if (cc + 8 < 128) SC_LOAD(rawN, cc + 8);
                SC_BARRIER();
            }
#undef SC_LOAD
#undef SC_FLUSH
        } else {
            if (c.wave >= 2) {
                const bf16* ZA = (const bf16*)(ws + WS_ZA); const bf16* VT = (const bf16*)(ws + WS_VT); bf16* OA = (bf16*)(ws + WS_OA);
                bf16x8 pf[8]; float inv = 0.f; f32x4 Sa[8][2];
#pragma unroll
                for (int r = 0; r < 8; ++r) { pf[r] = (bf16x8){0, 0, 0, 0, 0, 0, 0, 0}; Sa[r][0] = Z4; Sa[r][1] = Z4; }
#pragma unroll 1
                for (int it = -1; it < 34; ++it) {
                    const int pi = it + 1;
                    if (pi < 32) { const int id = job * 32 + 2 * (pi >> 2) + (c.wave - 2);
                        NaTask t; t.cq = id & 3; t.i = (id >> 2) & 127; t.h = (id >> 9) & 7; t.b = id >> 12;
                        const int part = pi & 3;
                        if (part == 0) na_part_a(ZA, rpbl, lane, t, 0, Sa, pf, inv); else if (part == 1) na_part_a(ZA, rpbl, lane, t, 1, Sa, pf, inv);
                        else if (part == 2) na_part_b(VT, OA, lane, t, 0, pf, inv); else na_part_b(VT, OA, lane, t, 1, pf, inv); }
                    SC_BARRIER();
                }
            } else {
            f32x4 S[2][4], P[2][4];
#pragma unroll
            for (int vv = 0; vv < 2; ++vv)
#pragma unroll
                for (int jt = 0; jt < 4; ++jt) { S[vv][jt] = Z4;
#pragma unroll
                    for (int rg = 0; rg < 4; ++rg) P[vv][jt][rg] = (16 * jt + 4 * kq + rg == 16 * (2 * c.wave + vv) + l15) ? 1.0f : 0.0f; }
#pragma unroll 1
            for (int it = -1; it < 34; ++it) {
                if (it >= 0 && it < 32) {
#pragma unroll 1
                    for (int q = 0; q < 4; ++q) {
                        LAS unsigned char* slot = c.lds + ((it & 1) * 4 + q) * SC_SLOT;
                        const bf16x8 at0 = *(const LAS bf16x8*)(slot + lane * 16), at1 = *(const LAS bf16x8*)(slot + 1024 + lane * 16);
                        const bf16x8 rt0 = *(const LAS bf16x8*)(slot + 2048 + lane * 16), rt1 = *(const LAS bf16x8*)(slot + 3072 + lane * 16);
                        const bf16x4 Ta = *(const LAS bf16x4*)(slot + 8192 + lane * 8), Mrb = *(const LAS bf16x4*)(slot + 8704 + lane * 8), Mrk = *(const LAS bf16x4*)(slot + 9216 + lane * 8);
                        bf16x8 bkf[4]; f32x4 gam[4];
#pragma unroll
                        for (int jt = 0; jt < 4; ++jt) { gam[jt] = *(const LAS f32x4*)(slot + 9728 + (16 * jt + 4 * kq) * 4); bkf[jt] = *(const LAS bf16x8*)(slot + 4096 + jt * 1024 + lane * 16); }
#pragma unroll
                        for (int vv = 0; vv < 2; ++vv) {
                            const int vt = 2 * c.wave + vv;
                            const bf16x4 Vf = *(const LAS bf16x4*)(slot + 9984 + vt * 1536 + lane * 8);
                            const f32x4 W2 = *(const LAS f32x4*)(slot + 9984 + vt * 1536 + 512 + lane * 16);
                            const bf16x8 sp0 = pack8(S[vv][0], S[vv][1]), sp1 = pack8(S[vv][2], S[vv][3]);
                            f32x4 X = mfma32(at0, sp0, W2); X = mfma32(at1, sp1, X);
                            f32x4 Oc = mfma32(rt0, sp0, Z4); Oc = mfma32(rt1, sp1, Oc);
                            const f32x4 U = mfma16(Ta, pack4(X), Z4);
                            const bf16x4 Up = pack4(U);
                            Oc = mfma16(Mrb, Up, Oc); Oc = mfma16(Mrk, Vf, Oc);
                            const v2u upw = __builtin_bit_cast(v2u, Up), vfw = __builtin_bit_cast(v2u, Vf);
                            const bf16x8 UV = __builtin_bit_cast(bf16x8, ((v4u){upw.x, upw.y, vfw.x, vfw.y}));
                            const bf16x8 pp0 = pack8(P[vv][0], P[vv][1]), pp1 = pack8(P[vv][2], P[vv][3]);
                            f32x4 Xp = mfma32(at0, pp0, Z4); Xp = mfma32(at1, pp1, Xp);
                            f32x4 Op = mfma32(rt0, pp0, Z4); Op = mfma32(rt1, pp1, Op);
                            const bf16x4 Upp = pack4(mfma16(Ta, pack4(Xp), Z4));
                            Op = mfma16(Mrb, Upp, Op);
                            const v2u uppw = __builtin_bit_cast(v2u, Upp);
                            const bf16x8 UVp = __builtin_bit_cast(bf16x8, ((v4u){uppw.x, uppw.y, 0u, 0u}));
#pragma unroll
                            for (int jt = 0; jt < 4; ++jt) { S[vv][jt] = mfma32(bkf[jt], UV, S[vv][jt] * gam[jt]); P[vv][jt] = mfma32(bkf[jt], UVp, P[vv][jt] * gam[jt]); }
                            LAS bf16* ost = (LAS bf16*)(slot + 9984 + vt * 1536 + 512);
#pragma unroll
                            for (int rg = 0; rg < 4; ++rg) { ost[(4 * kq + rg) * 16 + l15] = (bf16)(cvtpk(Oc[rg], 0.f) & 0xffffu); ost[256 + (4 * kq + rg) * 16 + l15] = (bf16)(cvtpk(Op[rg], 0.f) & 0xffffu); }
                        }
                    }
                }
                SC_BARRIER();
            }
            float* QS = (float*)(ws + WS_QS) + (size_t)job * 4096; float* PS = (float*)(ws + WS_PS) + (size_t)job * 4096;
#pragma unroll
            for (int vv = 0; vv < 2; ++vv)
#pragma unroll
                for (int jt = 0; jt < 4; ++jt) { const int vt = 2 * c.wave + vv;
                    *(f32x4*)(QS + (16 * vt + l15) * 64 + 16 * jt + 4 * kq) = S[vv][jt]; *(f32x4*)(PS + (16 * vt + l15) * 64 + 16 * jt + 4 * kq) = P[vv][jt]; }
            }
        }
    }
}
DI void phase_scan_chain(const Args& a, const Ctx& c) {
    unsigned char* ws = a.ws;
    LAS float* Sc = (LAS float*)c.lds;
    LAS float* Pm = (LAS float*)(c.lds + 16640);
    const int v = c.tid >> 3, jg = c.tid & 7;
    for (int p = c.bid; p < 64; p += c.G) {
        const float* QS = (const float*)(ws + WS_QS) + (size_t)p * 4 * 4096; const float* PS = (const float*)(ws + WS_PS) + (size_t)p * 4 * 4096;
        bf16* SST = (bf16*)(ws + WS_SST) + (size_t)p * 4 * 4096;
        float acc[8];
#pragma unroll
        for (int e = 0; e < 8; ++e) acc[e] = QS[v * 64 + 8 * jg + e];
#pragma unroll 1
        for (int seg = 1; seg < 4; ++seg) {
            __syncthreads();
#pragma unroll
            for (int e = 0; e < 8; ++e) Sc[v * 65 + 8 * jg + e] = acc[e];
            { v4u o; o.x = pk2(acc[0], acc[1]); o.y = pk2(acc[2], acc[3]); o.z = pk2(acc[4], acc[5]); o.w = pk2(acc[6], acc[7]); *(v4u*)(SST + seg * 4096 + v * 64 + 8 * jg) = o; }
            if (seg == 3) break;
            for (int i = 0; i < 8; ++i) Pm[c.tid + 512 * i] = PS[seg * 4096 + c.tid + 512 * i];
            __syncthreads();
#pragma unroll
            for (int e = 0; e < 8; ++e) acc[e] = QS[seg * 4096 + v * 64 + 8 * jg + e];
            for (int i = 0; i < 64; ++i) { const float sv = Sc[v * 65 + i];
#pragma unroll
                for (int e = 0; e < 8; ++e) acc[e] += sv * Pm[i * 64 + 8 * jg + e]; }
        }
        __syncthreads();
    }
}
DI void phase_scan_fix(const Args& a, const Ctx& c) {
    unsigned char* ws = a.ws;
    const int lane = c.lane, l15 = lane & 15, kq = lane >> 4;
    const f32x4 Z4 = (f32x4){0.f, 0.f, 0.f, 0.f};
    for (int item = c.gw; item < 64 * 3 * 128; item += c.NGW) {
        const int tile = item & 127, ps = item >> 7, seg = 1 + ps % 3, p = ps / 3, dir = p >> 5, b = (p >> 4) & 1, h = p & 15;
        const bf16* PHI = (const bf16*)(ws + (dir ? WS_PHIB : WS_PHIF)); bf16* O = (bf16*)(ws + (dir ? WS_OBW : WS_OF));
        const bf16* SST = (const bf16*)(ws + WS_SST) + (size_t)(p * 4 + seg) * 4096;
        const int ng0 = 16 * (128 * seg + tile);
        const size_t pa = (size_t)(b * 6144 + ng0 + l15 - 2048) * 1024 + h * 64;
        const bf16x8 a0 = *(const bf16x8*)(PHI + pa + 8 * kq), a1 = *(const bf16x8*)(PHI + pa + 32 + 8 * kq);
#pragma unroll
        for (int vt = 0; vt < 4; ++vt) {
            const bf16x8 b0 = *(const bf16x8*)(SST + (16 * vt + l15) * 64 + 8 * kq), b1 = *(const bf16x8*)(SST + (16 * vt + l15) * 64 + 32 + 8 * kq);
            f32x4 cc = mfma32(a0, b0, Z4); cc = mfma32(a1, b1, cc);
#pragma unroll
            for (int rg = 0; rg < 4; ++rg) { const int ng = ng0 + 4 * kq + rg, t = dir ? (SEQ - 1 - ng) : ng;
                bf16* op = O + (size_t)(b * SEQ + t) * 1024 + h * 64 + 16 * vt + l15;
                *op = (bf16)(cvtpk(bflo((unsigned)*op) + cc[rg], 0.f) & 0xffffu); }
        }
    }
}

DI void phase_rwkv_post(const Args& a, const Ctx& c) {
    unsigned char* ws = a.ws;
    const bf16* OF = (const bf16*)(ws + WS_OF); const bf16* OB = (const bf16*)(ws + WS_OBW);
    const bf16* R16 = (const bf16*)(ws + WS_R); const bf16* K16 = (const bf16*)(ws + WS_K); const bf16* V16 = (const bf16*)(ws + WS_V); const bf16* G16 = (const bf16*)(ws + WS_G);
    bf16* OUT = (bf16*)(ws + WS_OB16);
    const int c0 = c.lane * 16;
    float rk[16], lnw[16], lnb[16];
#pragma unroll
    for (int e = 0; e < 16; ++e) { rk[e] = a.in[19][c0 + e]; lnw[e] = a.in[20][c0 + e]; lnb[e] = a.in[21][c0 + e]; }
    for (int row = c.gw; row < MROWS; row += c.NGW) {
        const size_t off = (size_t)row * 1024 + c0;
        float o[16], r[16], k[16], v[16], g[16];
#pragma unroll
        for (int hh = 0; hh < 2; ++hh) {
            const v4u uf = *(const v4u*)(OF + off + 8 * hh), ub = *(const v4u*)(OB + off + 8 * hh), ur = *(const v4u*)(R16 + off + 8 * hh), uk = *(const v4u*)(K16 + off + 8 * hh),
                      uv = *(const v4u*)(V16 + off + 8 * hh), ug = *(const v4u*)(G16 + off + 8 * hh);
            const unsigned f4[4] = {uf.x, uf.y, uf.z, uf.w}, b4[4] = {ub.x, ub.y, ub.z, ub.w}, r4[4] = {ur.x, ur.y, ur.z, ur.w}, k4[4] = {uk.x, uk.y, uk.z, uk.w}, v4[4] = {uv.x, uv.y, uv.z, uv.w}, g4[4] = {ug.x, ug.y, ug.z, ug.w};
#pragma unroll
            for (int e = 0; e < 4; ++e) { const int i0 = 8 * hh + 2 * e;
                o[i0] = bflo(f4[e]) + bflo(b4[e]); o[i0 + 1] = bfhi(f4[e]) + bfhi(b4[e]);
                r[i0] = bflo(r4[e]); r[i0 + 1] = bfhi(r4[e]); k[i0] = bflo(k4[e]); k[i0 + 1] = bfhi(k4[e]);
                v[i0] = bflo(v4[e]); v[i0 + 1] = bfhi(v4[e]); g[i0] = bflo(g4[e]); g[i0 + 1] = bfhi(g4[e]); }
        }
        float s = 0.f, bs = 0.f;
#pragma unroll
        for (int e = 0; e < 16; ++e) { s += o[e]; bs += r[e] * k[e] * rk[e]; }
        s += __shfl_xor(s, 1); s += __shfl_xor(s, 2); bs += __shfl_xor(bs, 1); bs += __shfl_xor(bs, 2);
        const float mean = s * (1.0f / 64.0f);
        float q = 0.f;
#pragma unroll
        for (int e = 0; e < 16; ++e) { o[e] -= mean; q += o[e] * o[e]; }
        q += __shfl_xor(q, 1); q += __shfl_xor(q, 2);
        const float rstd = rsqrtf(q * (1.0f / 64.0f) + 64e-5f);
        float y[16];
#pragma unroll
        for (int e = 0; e < 16; ++e) y[e] = (o[e] * rstd * lnw[e] + lnb[e] + bs * v[e]) * g[e];
        int t[4];
#pragma unroll
        for (int q = 0; q < 4; ++q) { t[q] = 0; t[q] = __builtin_amdgcn_cvt_pk_fp8_f32(c448(y[4 * q] * 16.f), c448(y[4 * q + 1] * 16.f), t[q], false); t[q] = __builtin_amdgcn_cvt_pk_fp8_f32(c448(y[4 * q + 2] * 16.f), c448(y[4 * q + 3] * 16.f), t[q], true); }
        v4u w0; w0.x = (unsigned)t[0]; w0.y = (unsigned)t[1]; w0.z = (unsigned)t[2]; w0.w = (unsigned)t[3];
        *(v4u*)((unsigned char*)OUT + off) = w0;
    }
}

DI void tables_load(const Args& a, int lane, int rp, f32x4 (&v)[2][8]) {
    if (rp >= 16384) return;
#pragma unroll
    for (int z = 0; z < 2; ++z) { const int rowi = 2 * rp + z, tb = rowi >> 14, row = rowi & 16383;
        const float* src = a.in[28 + tb] + (size_t)row * 2048 + lane * 4;
#pragma unroll
        for (int i = 0; i < 8; ++i) v[z][i] = *(const f32x4*)(src + 256 * i); }
}
DI void tables_finish(const Args& a, int lane, int rp, f32x4 (&v)[2][8]) {
    if (rp >= 16384) return;
    float* SC = (float*)(a.ws + WS_PSC);
    float mx[2];
#pragma unroll
    for (int z = 0; z < 2; ++z) { float m = 0.f;
#pragma unroll
        for (int i = 0; i < 8; ++i) m = fmaxf(m, fmaxf(fmaxf(fabsf(v[z][i].x), fabsf(v[z][i].y)), fmaxf(fabsf(v[z][i].z), fabsf(v[z][i].w))));
        mx[z] = wave_max_fast(m); }
#pragma unroll
    for (int z = 0; z < 2; ++z) { const int rowi = 2 * rp + z, tb = rowi >> 14, row = rowi & 16383;
        const float scale = (mx[z] > 0.f) ? mx[z] * (1.0f / 224.0f) : 1.0f, inv = 1.0f / scale;
        unsigned char* dst = a.ws + (tb ? WS_PV : WS_PU) + ((size_t)(lane >> 5) * 16384 + row) * 128 + ((lane * 4) & 127);
#pragma unroll
        for (int i = 0; i < 8; ++i) { int t = 0; t = __builtin_amdgcn_cvt_pk_fp8_f32(v[z][i].x * inv, v[z][i].y * inv, t, false); t = __builtin_amdgcn_cvt_pk_fp8_f32(v[z][i].z * inv, v[z][i].w * inv, t, true);
            *(unsigned*)(dst + (size_t)(2 * i) * 16384 * 128) = (unsigned)t; }
        if (lane == 0) SC[rowi] = scale; }
}

DI void sort8_desc(float (&a)[8]) {
#define R_CE(i, j) { const float hi_ = fmaxf(a[i], a[j]), lo_ = fminf(a[i], a[j]); a[i] = hi_; a[j] = lo_; }
    R_CE(0, 1) R_CE(2, 3) R_CE(4, 5) R_CE(6, 7)
    R_CE(0, 2) R_CE(1, 3) R_CE(4, 6) R_CE(5, 7)
    R_CE(1, 2) R_CE(5, 6)
    R_CE(0, 4) R_CE(1, 5) R_CE(2, 6) R_CE(3, 7)
    R_CE(2, 4) R_CE(3, 5)
    R_CE(1, 2) R_CE(3, 4) R_CE(5, 6)
#undef R_CE
}
template <int NCH> DI void top16_rows(float (&a)[NCH][8], int i, float (&outv)[NCH], int (&outi)[NCH]) {
#pragma unroll
    for (int ch = 0; ch < NCH; ++ch) { outv[ch] = 0.f; outi[ch] = 0; sort8_desc(a[ch]); }
#pragma unroll 1
    for (int it = 0; it < 16; ++it) {
#pragma unroll
        for (int ch = 0; ch < NCH; ++ch) {
            const float wm = row16_max(a[ch][0]);
            const bool own = (a[ch][0] == wm);
#pragma unroll
            for (int k = 0; k < 7; ++k) a[ch][k] = own ? a[ch][k + 1] : a[ch][k];
            a[ch][7] = own ? -INFINITY : a[ch][7];
            if (i == it) { outv[ch] = __uint_as_float(__float_as_uint(wm) & ~127u); outi[ch] = (int)(__float_as_uint(wm) & 127u); }
        }
    }
}
DI void phase_route(const Args& a, const Ctx& c) {
    unsigned char* ws = a.ws;
    const float* SC = (const float*)(ws + WS_SC);
    int* EIDX = (int*)(ws + WS_EIDX); float* EGV = (float*)(ws + WS_EGV);
    const int lane = c.lane, r = lane >> 4, i = lane & 15, rowbase = lane & 48;
    int trip = 0;
    for (int tp = c.gw; tp < MROWS / 2; tp += c.NGW, ++trip) {
        f32x4 trow[2][8];
        const int rpA = c.gw + c.NGW * (2 * trip), rpB = rpA + c.NGW;
        tables_load(a, lane, rpA, trow);
        float sc[8][8];
#pragma unroll
        for (int ch = 0; ch < 8; ++ch) { const float* sp = SC + (size_t)(2 * tp + (ch >> 2)) * 2048 + (4 * ((ch >> 1) & 1) + r) * 256 + 128 * (ch & 1);
#pragma unroll
            for (int k = 0; k < 8; ++k) sc[ch][k] = __uint_as_float((__float_as_uint(sp[i + 16 * k]) & ~127u) | (unsigned)(i + 16 * k)); }
        float tv_[8]; int ti_[8];
        top16_rows<8>(sc, i, tv_, ti_);
        tables_finish(a, lane, rpA, trow);
        tables_load(a, lane, rpB, trow);
        int p[4] = {0, 0, 0, 0}; float cand[4], tv[4] = {0.f, 0.f, 0.f, 0.f}; int tf[4] = {0, 0, 0, 0};
#pragma unroll
        for (int ps = 0; ps < 4; ++ps) cand[ps] = __uint_as_float((__float_as_uint(tv_[2 * ps] + __shfl(tv_[2 * ps + 1], rowbase)) & ~255u) | (unsigned)(i << 4));
#pragma unroll 1
        for (int it = 0; it < 16; ++it) {
#pragma unroll
            for (int ps = 0; ps < 4; ++ps) {
                const float wm = row16_max(cand[ps]);
                if (i == it) { tv[ps] = __uint_as_float(__float_as_uint(wm) & ~255u); tf[ps] = (int)(__float_as_uint(wm) & 255u); }
                if (cand[ps] == wm) p[ps] += 1;
                const float nv = __shfl(tv_[2 * ps + 1], rowbase | (p[ps] & 15));
                cand[ps] = (p[ps] < 16) ? __uint_as_float((__float_as_uint(tv_[2 * ps] + nv) & ~255u) | (unsigned)((i << 4) | p[ps])) : -INFINITY;
            }
        }
#pragma unroll
        for (int ps = 0; ps < 4; ++ps) {
            const int token = 2 * tp + (ps >> 1), h = 4 * (ps & 1) + r;
            const int ia = __shfl(ti_[2 * ps], rowbase | (tf[ps] >> 4)), ib = __shfl(ti_[2 * ps + 1], rowbase | (tf[ps] & 15));
            const float t0 = __shfl(tv[ps], rowbase);
            const float ex = __expf(tv[ps] - t0);
            const float sm = row16_sum(ex);
            const int id = ia * 128 + ib;
            const size_t o = (size_t)token * 128 + h * 16 + i;
            EIDX[o] = id; EGV[o] = ex / sm;
        }
        tables_finish(a, lane, rpB, trow);
    }
}

DI float dot16_fp8(const v4u w, const float* x) {
    float s = 0.f;
    const unsigned ww[4] = {w.x, w.y, w.z, w.w};
#pragma unroll
    for (int q = 0; q < 4; ++q) { const f32x2 lo = __builtin_amdgcn_cvt_pk_f32_fp8((int)ww[q], false), hi = __builtin_amdgcn_cvt_pk_f32_fp8((int)ww[q], true);
        s += x[4 * q] * lo.x + x[4 * q + 1] * lo.y + x[4 * q + 2] * hi.x + x[4 * q + 3] * hi.y; }
    return s;
}
DI void axpy16_fp8(const v4u w, float g, float* acc) {
    const unsigned ww[4] = {w.x, w.y, w.z, w.w};
#pragma unroll
    for (int q = 0; q < 4; ++q) { const f32x2 lo = __builtin_amdgcn_cvt_pk_f32_fp8((int)ww[q], false), hi = __builtin_amdgcn_cvt_pk_f32_fp8((int)ww[q], true);
        acc[4 * q] += g * lo.x; acc[4 * q + 1] += g * lo.y; acc[4 * q + 2] += g * hi.x; acc[4 * q + 3] += g * hi.y; }
}
DI void peer_item(const Ctx& c, int it, int& s, int& tok0) { s = 2 * (it & 7) + (it >> 8); tok0 = ((it >> 3) & 31) * 512 + c.wave * 64; }
#define PEER_PIN4(v) asm volatile("" : "+v"(v.x), "+v"(v.y), "+v"(v.z), "+v"(v.w))
DI void phase_peer_u(const Args& a, const Ctx& c) {
    unsigned char* ws = a.ws;
    const bf16* U2 = (const bf16*)(ws + WS_U2); const int* EIDX = (const int*)(ws + WS_EIDX); float* HP = (float*)(ws + WS_HP);
    const int lane = c.lane, g = lane >> 3, part = lane & 7;
#pragma unroll 1
    for (int it = c.bid; it < 512; it += c.G) {
        int s, tok0; peer_item(c, it, s, tok0);
        const unsigned char* tab = ws + WS_PU + (size_t)s * 16384 * 128 + part * 16;
        v4u idn[2][4], xn[2][2];
#define PU_REQ(tk) do { _Pragma("unroll") for (int z_ = 0; z_ < 2; ++z_) { const size_t t_ = (size_t)((tk) + z_); \
            _Pragma("unroll") for (int q_ = 0; q_ < 4; ++q_) idn[z_][q_] = *(const v4u*)(EIDX + t_ * 128 + 16 * g + 4 * q_); \
            xn[z_][0] = *(const v4u*)(U2 + t_ * 2048 + 128 * s + 16 * part); xn[z_][1] = *(const v4u*)(U2 + t_ * 2048 + 128 * s + 16 * part + 8); } } while (0)
        PU_REQ(tok0);
#pragma unroll 1
        for (int tt = 0; tt < 64; tt += 2) {
            const int token = tok0 + tt;
            v4u w[2][16]; float x[2][16];
#pragma unroll
            for (int z = 0; z < 2; ++z) {
                const unsigned idv[16] = {idn[z][0].x, idn[z][0].y, idn[z][0].z, idn[z][0].w, idn[z][1].x, idn[z][1].y, idn[z][1].z, idn[z][1].w, idn[z][2].x, idn[z][2].y, idn[z][2].z, idn[z][2].w, idn[z][3].x, idn[z][3].y, idn[z][3].z, idn[z][3].w};
#pragma unroll
                for (int i = 0; i < 16; ++i) w[z][i] = *(const v4u*)(tab + (size_t)idv[i] * 128);
                const v4u u0 = xn[z][0], u1 = xn[z][1];
                x[z][0] = bflo(u0.x); x[z][1] = bfhi(u0.x); x[z][2] = bflo(u0.y); x[z][3] = bfhi(u0.y); x[z][4] = bflo(u0.z); x[z][5] = bfhi(u0.z); x[z][6] = bflo(u0.w); x[z][7] = bfhi(u0.w);
                x[z][8] = bflo(u1.x); x[z][9] = bfhi(u1.x); x[z][10] = bflo(u1.y); x[z][11] = bfhi(u1.y); x[z][12] = bflo(u1.z); x[z][13] = bfhi(u1.z); x[z][14] = bflo(u1.w); x[z][15] = bfhi(u1.w);
            }
            if (tt + 2 < 64) PU_REQ(token + 2);
#pragma unroll
            for (int z = 0; z < 2; ++z) {
                float hv0 = 0.f, hv1 = 0.f;
#pragma unroll
                for (int i = 0; i < 16; ++i) { const float d = group8_sum(dot16_fp8(w[z][i], x[z])); if (part == (i & 7)) { if (i < 8) hv0 = d; else hv1 = d; } }
                float* hp = HP + ((size_t)s * MROWS + token + z) * 128 + 16 * g + part;
                hp[0] = hv0; hp[8] = hv1;
            }
#pragma unroll
            for (int z = 0; z < 2; ++z) { PEER_PIN4(idn[z][0]); PEER_PIN4(idn[z][1]); PEER_PIN4(idn[z][2]); PEER_PIN4(idn[z][3]); PEER_PIN4(xn[z][0]); PEER_PIN4(xn[z][1]); }
        }
#undef PU_REQ
    }
}
DI void phase_peer_h(const Args& a, const Ctx& c) {
    unsigned char* ws = a.ws;
    const float* HP = (const float*)(ws + WS_HP); const int* EIDX = (const int*)(ws + WS_EIDX); const float* PSC = (const float*)(ws + WS_PSC); const float* EGV = (const float*)(ws + WS_EGV); float* GVP = (float*)(ws + WS_GVP);
    for (int i = c.bid * 512 + c.tid; i < MROWS * 128; i += c.G * 512) {
        const int id = EIDX[i];
        float h = 0.f;
#pragma unroll
        for (int s = 0; s < 16; ++s) h += HP[(size_t)s * MROWS * 128 + i];
        h *= PSC[id];
        GVP[i] = 0.5f * h * (1.0f + erff(h * 0.70710678118654752f)) * EGV[i] * PSC[16384 + id];
    }
}
DI void phase_peer_v(const Args& a, const Ctx& c) {
    unsigned char* ws = a.ws;
    const int* EIDX = (const int*)(ws + WS_EIDX); const float* GVP = (const float*)(ws + WS_GVP); const float* mod = (const float*)(ws + WS_MOD);
    const int lane = c.lane, g = lane >> 3, part = lane & 7;
#pragma unroll 1
    for (int it = c.bid; it < 512; it += c.G) {
        int s, tok0; peer_item(c, it, s, tok0);
        const unsigned char* tab = ws + WS_PV + (size_t)s * 16384 * 128 + part * 16;
        v4u idn[4]; f32x4 gn[4];
#define PV_REQ(tk) do { const size_t t_ = (size_t)(tk); \
            _Pragma("unroll") for (int q_ = 0; q_ < 4; ++q_) { idn[q_] = *(const v4u*)(EIDX + t_ * 128 + 16 * g + 4 * q_); gn[q_] = *(const f32x4*)(GVP + t_ * 128 + 16 * g + 4 * q_); } } while (0)
        PV_REQ(tok0);
#pragma unroll 1
        for (int tt = 0; tt < 64; ++tt) {
            const int token = tok0 + tt;
            v4u w[16]; float gv[16];
            const unsigned idv[16] = {idn[0].x, idn[0].y, idn[0].z, idn[0].w, idn[1].x, idn[1].y, idn[1].z, idn[1].w, idn[2].x, idn[2].y, idn[2].z, idn[2].w, idn[3].x, idn[3].y, idn[3].z, idn[3].w};
#pragma unroll
            for (int i = 0; i < 16; ++i) w[i] = *(const v4u*)(tab + (size_t)idv[i] * 128);
#pragma unroll
            for (int q = 0; q < 4; ++q) { gv[4 * q] = gn[q].x; gv[4 * q + 1] = gn[q].y; gv[4 * q + 2] = gn[q].z; gv[4 * q + 3] = gn[q].w; }
            if (tt + 1 < 64) PV_REQ(token + 1);
            float acc[16];
#pragma unroll
            for (int i = 0; i < 16; ++i) acc[i] = 0.f;
#pragma unroll
            for (int i = 0; i < 16; ++i) axpy16_fp8(w[i], gv[i], acc);
#pragma unroll
            for (int i = 0; i < 16; ++i) { float v = acc[i]; v += dpp_mov<0x128>(v); v += __shfl_xor(v, 16); v += __shfl_xor(v, 32); acc[i] = v; }
            if (g == 0) {
                const int b = token >> 13, col = 128 * s + 16 * part;
                const float* g2 = mod + (size_t)b * 12288 + 10240 + col; float* op = a.out + (size_t)token * 2048 + col;
#pragma unroll
                for (int q = 0; q < 4; ++q) { const f32x4 xa = *(const f32x4*)(op + 4 * q), ga = *(const f32x4*)(g2 + 4 * q);
                    f32x4 o; o.x = xa.x + ga.x * acc[4 * q]; o.y = xa.y + ga.y * acc[4 * q + 1]; o.z = xa.z + ga.z * acc[4 * q + 2]; o.w = xa.w + ga.w * acc[4 * q + 3];
                    *(f32x4*)(op + 4 * q) = o; }
            }
#pragma unroll
            for (int q = 0; q < 4; ++q) { PEER_PIN4(idn[q]); PEER_PIN4(gn[q]); }
        }
#undef PV_REQ
    }
}

__global__ void __launch_bounds__(NWAVES * 64, 2) hybrid_fwd(Args args) {
    extern __shared__ __attribute__((aligned(16))) unsigned char lds[];
    Ctx c;
#define FRESH_CTX() do { int t_ = threadIdx.x; asm volatile("" : "+v"(t_)); c.lds = (LAS unsigned char*)lds; c.tid = t_; c.lane = c.tid & 63; c.wave = __builtin_amdgcn_readfirstlane(c.tid >> 6); \
    c.G = gridDim.x; c.bid = blockIdx.x; c.gw = c.bid * NWAVES + c.wave; c.NGW = c.G * NWAVES; } while (0)
    FRESH_CTX();
    volatile LAS unsigned* MISC = (volatile LAS unsigned*)(c.lds + MISC_OFF);
    unsigned char* ws = args.ws;
    unsigned* ctl = (unsigned*)(ws + WS_CTL);
    if (c.tid < 32) MISC[c.tid] = 0u;
    __syncthreads();
    XcdBarrier bar; bar.bar = ctl + CW_BAR; bar.x = 0; bar.st = nullptr;
#if !MK_PER_PHASE
    bar = xcd_barrier_post(ctl + CW_BAR, MISC + 8);
#endif
    const int lo = args.ph_lo, hi = args.ph_hi;
#ifndef PHASE_MASK
#define PHASE_MASK 0x3ffff
#endif
#define IN(k) ((((PHASE_MASK) >> (k)) & 1) && lo <= (k) && (k) < hi)
#define SEAM(k) do { if (IN(k) && IN((k) + 1)) xcd_barrier(bar); } while (0)
    const float* mod = (const float*)(ws + WS_MOD);
    LAS unsigned char* ring = c.lds;

    if (IN(0)) { FRESH_CTX(); phase_prologue(args, c); } SEAM(0);
    if (IN(1)) { FRESH_CTX(); phase_norm_mod<true>(c, args.in[0], args.in[4], mod, 0, 2048, (bf16*)(ws + WS_U16)); } SEAM(1);
    if (IN(2)) {
        pg8::Gemm g{(const pg8::bf16_t*)(ws + WS_U16), (const pg8::bf16_t*)(ws + WS_WIN), MROWS, NZ, DM / 2, nullptr, nullptr, 0x75757575u, 0x7C7C7C7Cu}; pg8::StaticOrder S; S.init(MROWS, NZ, c.G, c.bid);
        pg8::EpiZ E{(pg8::bf16_t*)(ws + WS_ZA), (pg8::bf16_t*)(ws + WS_ZB), (pg8::bf16_t*)args.out, args.in[7]};
        pg8::gemm_phase<pg8::EpiZ, pg8::StaticOrder, true, true, false, true>(ring, g, S, E);
    } SEAM(2);
    if (IN(3)) { FRESH_CTX(); phase_qknorm_prep(args, c); phase_vtranspose(args, c); } SEAM(3);
    if (IN(4)) {
        pg8::Gemm g{(const pg8::bf16_t*)(ws + WS_T), (const pg8::bf16_t*)(ws + WS_LORA), MROWS, 5120, 256};
        pg8::GroupedOrder S; S.init(MROWS, 5120, c.G, c.bid); S.a_stride = (size_t)MROWS * 256 * 2;
        pg8::EpiLora E{{(pg8::bf16_t*)(ws + WS_LWF), (pg8::bf16_t*)(ws + WS_LWB), (pg8::bf16_t*)(ws + WS_ICF), (pg8::bf16_t*)(ws + WS_ICB), (pg8::bf16_t*)(ws + WS_G)},
                       {args.in[12], args.in[12] + 1024, args.in[14], args.in[14] + 1024, args.in[14]}};
        pg8::gemm_phase<pg8::EpiLora, pg8::GroupedOrder, true, true>(ring, g, S, E);
    }
    if (IN(5)) { FRESH_CTX(); phase_na_attention(args, c); }
    do { if ((IN(4) || IN(5)) && IN(6)) xcd_barrier(bar); } while (0);
    if (IN(6)) { FRESH_CTX(); phase_scan(args, c); } SEAM(6);
    if (IN(7)) { FRESH_CTX(); phase_scan_chain(args, c); } SEAM(7);
    if (IN(8)) { FRESH_CTX(); phase_scan_fix(args, c); } SEAM(8);
    if (IN(9)) { FRESH_CTX(); phase_rwkv_post(args, c); } SEAM(9);
    if (IN(10)) {
        pg8::Gemm g{(const pg8::bf16_t*)(ws + WS_OA), (const pg8::bf16_t*)(ws + WS_WA), MROWS, DM, 1024, (const pg8::bf16_t*)(ws + WS_OB16), (const pg8::bf16_t*)(ws + WS_WB), 0x76767676u, 0x7B7B7B7Bu};
        pg8::StaticOrder S; S.init(MROWS, DM, c.G, c.bid);
        pg8::EpiGate2 E{(pg8::bf16_t*)(ws + WS_MERGED), (const pg8::bf16_t*)args.out};
        pg8::gemm_phase<pg8::EpiGate2, pg8::StaticOrder, true, true, true, true>(ring, g, S, E);
    } SEAM(10);
    if (IN(11)) {
        pg8::Gemm g{(const pg8::bf16_t*)(ws + WS_MERGED), (const pg8::bf16_t*)(ws + WS_WOUT), MROWS, DM, DM / 2, nullptr, nullptr, 0x75757575u, 0x7A7A7A7Au}; pg8::StaticOrder S; S.init(MROWS, DM, c.G, c.bid);
        pg8::EpiRes E{args.in[0], args.out, mod + 4096, 12288};
        pg8::gemm_phase<pg8::EpiRes, pg8::StaticOrder, true, true, false, true>(ring, g, S, E);
    } SEAM(11);
    if (IN(12)) { FRESH_CTX(); phase_norm_mod<false>(c, args.out, args.in[5], mod, 6144, 8192, (bf16*)(ws + WS_U2)); } SEAM(12);
    if (IN(13)) {
        pg8::Gemm g{(const pg8::bf16_t*)(ws + WS_U2), (const pg8::bf16_t*)(ws + WS_WQS), MROWS, DM, DM}; pg8::StaticOrder S; S.init(MROWS, DM, c.G, c.bid);
        pg8::EpiRes E{nullptr, (float*)(ws + WS_SC), nullptr, 0};
        pg8::gemm_phase<pg8::EpiRes, pg8::StaticOrder, true, true>(ring, g, S, E);
    } SEAM(13);
    if (IN(14)) { FRESH_CTX(); phase_route(args, c); } SEAM(14);
    if (IN(15)) { FRESH_CTX(); phase_peer_u(args, c); } SEAM(15);
    if (IN(16)) { FRESH_CTX(); phase_peer_h(args, c); } SEAM(16);
    if (IN(17)) { FRESH_CTX(); phase_peer_v(args, c); }
#undef IN
#undef SEAM
}

extern "C" void kernel_launch(void* const* d_in, const int* in_sizes, int n_in, void* d_out, int out_size, void* d_ws, size_t ws_size, hipStream_t stream) {
    static int grid = 0;
    if (grid == 0) {
        if (n_in != 30 || in_sizes[0] != MROWS * DM || out_size != MROWS * DM || ws_size < WS_END) {
            fprintf(stderr, "kernel_launch: unexpected problem (n_in %d, in0 %d, out %d, ws %zu; need ws >= %zu); nothing launched\n", n_in, n_in > 0 ? in_sizes[0] : -1, out_size, ws_size, (size_t)WS_END); grid = -1; return; }
        int dev = 0, cus = 0, per_cu = 0;
        if (hipGetDevice(&dev) != hipSuccess || hipDeviceGetAttribute(&cus, hipDeviceAttributeMultiprocessorCount, dev) != hipSuccess) { fprintf(stderr, "kernel_launch: device query failed\n"); grid = -1; return; }
        if (hipFuncSetAttribute((const void*)hybrid_fwd, hipFuncAttributeMaxDynamicSharedMemorySize, LDS_BYTES) != hipSuccess) { fprintf(stderr, "kernel_launch: hipFuncSetAttribute failed\n"); grid = -1; return; }
        if (hipOccupancyMaxActiveBlocksPerMultiprocessor(&per_cu, (const void*)hybrid_fwd, NWAVES * 64, LDS_BYTES) != hipSuccess || per_cu < 1)
            fprintf(stderr, "kernel_launch: note: occupancy query reports %d workgroups per CU\n", per_cu);
        (void)hipGetLastError();
        grid = cus;
        if (grid > 256) grid = 256;
    }
    if (grid < 0) return;
    if (hipMemsetAsync((char*)d_ws + WS_CTL, 0, CTL_ZERO_BYTES, stream) != hipSuccess) { fprintf(stderr, "kernel_launch: memset failed\n"); return; }
    Args a{};
    for (int i = 0; i < 30; ++i) a.in[i] = (const float*)d_in[i];
    a.out = (float*)d_out; a.ws = (unsigned char*)d_ws;
#if MK_PER_PHASE
    for (int p = 0; p < N_PHASES; ++p) { a.ph_lo = p; a.ph_hi = p + 1; hipLaunchKernelGGL(hybrid_fwd, dim3(grid), dim3(NWAVES * 64), LDS_BYTES, stream, a); }
#else
    a.ph_lo = 0; a.ph_hi = N_PHASES;
    hipLaunchKernelGGL(hybrid_fwd, dim3(grid), dim3(NWAVES * 64), LDS_BYTES, stream, a);
#endif
    const hipError_t le = hipPeekAtLastError();
    if (le != hipSuccess) fprintf(stderr, "kernel_launch: launch failed: %s\n", hipGetErrorName(le));
}
```

```cpp
#include <hip/hip_runtime.h>
#include <cstdio>
#include <cstdint>
#ifndef MK_PER_PHASE
#define MK_PER_PHASE 0
#endif
#ifndef DUP_PHASE
#define DUP_PHASE -1
#endif
namespace pg8 {
#define PG8_LAS __attribute__((address_space(3)))
typedef unsigned short bf16_t;
typedef short bf16x8 __attribute__((ext_vector_type(8)));
typedef float f32x4 __attribute__((ext_vector_type(4)));
typedef unsigned u32x4 __attribute__((ext_vector_type(4)));
constexpr int BM = 256, BK = 64, HALF = 128, HTB = HALF * BK * 2  , STAGE_BYTES = 8 * HTB, NXCD = 8, WGM = 8;

__host__ __device__ __forceinline__ int lds_byte(int r, int c) { const int st = (r >> 4) * 2 + (c >> 5), rr = r & 15, cc = c & 31, ob = rr * 64 + cc * 2; return st * 1024 + (ob ^ (((ob >> 9) & 1) << 5)); }
__host__ __device__ __forceinline__ void stage_rc(int b, int& R, int& C) { const int st = b / 1024, sb = b % 1024, swz = sb ^ (((sb >> 9) & 1) << 5); R = (st >> 1) * 16 + swz / 64; C = (st & 1) * 32 + (swz % 64) / 2; }
__host__ __device__ __forceinline__ int perm32(int rho) { const int n = rho >> 4, i = rho & 15; return 8 * (i >> 2) + 4 * n + (i & 3); }

struct Unit { int pm, pn; };
struct Gemm { const bf16_t* A; const bf16_t* Bt; int M, N, K; const bf16_t* A2; const bf16_t* Bt2; unsigned f8sb, f8sa; };
typedef int i32x4 __attribute__((ext_vector_type(4)));
typedef int i32x8 __attribute__((ext_vector_type(8)));
__device__ __forceinline__ i32x8 cat8(bf16x8 a, bf16x8 b) { return __builtin_shufflevector(__builtin_bit_cast(i32x4, a), __builtin_bit_cast(i32x4, b), 0, 1, 2, 3, 4, 5, 6, 7); }

struct StaticOrder {
    int nM, nN, nwg, G, c;
    __host__ __device__ void init(int M, int N, int G_, int c_) { nM = M / BM; nN = N / BM; nwg = nM * nN; G = G_; c = c_; }
    __host__ __device__ bool next(int i, Unit& u) const {
        const long L = (long)i * G + c; if (L >= nwg) return false;
        int wgid = (int)L; { const int q = nwg / NXCD, r = nwg % NXCD, xcd = wgid % NXCD, off = wgid / NXCD; wgid = (xcd < r ? xcd * (q + 1) : r * (q + 1) + (xcd - r) * q) + off; }
        const int nig = WGM * nN, gid = wgid / nig, fm = gid * WGM, gsz = (nM - fm) < WGM ? (nM - fm) : WGM;
        u.pm = fm + ((wgid % nig) % gsz); u.pn = (wgid % nig) / gsz; return true;
    }
    __device__ __forceinline__ size_t a_off(const Unit&) const { return 0; }
    __device__ __forceinline__ void a_ready(const Unit&) const {}
    __device__ __forceinline__ void done(const Unit&) const {}
};
struct GroupedOrder : StaticOrder { size_t a_stride; __device__ __forceinline__ size_t a_off(const Unit& u) const { return (size_t)(u.pn >> 2) * a_stride; } };
__device__ __forceinline__ unsigned cvt_pk_bf16(float lo, float hi) { unsigned r; asm volatile("v_cvt_pk_bf16_f32 %0, %1, %2" : "=v"(r) : "v"(lo), "v"(hi)); return r; }
typedef float f32x2 __attribute__((ext_vector_type(2)));
__device__ __forceinline__ float sigm(float x) { return 1.0f / (1.0f + __expf(-x)); }
__device__ __forceinline__ float bflo(unsigned u) { return __uint_as_float(u << 16); }
__device__ __forceinline__ float bfhi(unsigned u) { return __uint_as_float(u & 0xffff0000u); }

typedef unsigned zu32x2 __attribute__((ext_vector_type(2)));
__device__ __forceinline__ float z448(float x) { return __builtin_amdgcn_fmed3f(x, -448.f, 448.f); }
struct EpiZ {
    static constexpr bool PERM = true, AFTER_DRAIN = false;
    bf16_t *ZA, *ZB, *ZG; const float* bgate;
    __device__ __forceinline__ void operator()(const f32x4 (&acc)[2][2][4][2], const Unit& u, int wr, int wc, int fr, int fq) const {
        const int row0 = u.pm * BM + wr * 64 + fr;
        bf16_t* base; int ldc, colt; bool gate = false;
        if (u.pn < 12) { base = ZA; ldc = 3072; colt = u.pn * 256; }
        else if (u.pn < 27) { base = ZB; ldc = 3840; colt = (u.pn - 12) * 256; }
        else { base = ZG; ldc = 4096; colt = (u.pn - 27) * 256; gate = true; }
        const int col0 = colt + wc * 32 + 8 * fq;
        f32x4 bv[2][2];
#pragma unroll
        for (int bj = 0; bj < 2; ++bj)
#pragma unroll
            for (int n = 0; n < 2; ++n) bv[bj][n] = gate ? *(const f32x4*)(bgate + col0 + bj * HALF + 4 * n) : (f32x4){0.f, 0.f, 0.f, 0.f};
#pragma unroll
        for (int ai = 0; ai < 2; ++ai)
#pragma unroll
            for (int m = 0; m < 4; ++m) { bf16_t* rowp = base + (size_t)(row0 + ai * HALF + m * 16) * ldc + col0;
#pragma unroll
                for (int bj = 0; bj < 2; ++bj) { f32x4 v0 = acc[ai][bj][m][0] + bv[bj][0], v1 = acc[ai][bj][m][1] + bv[bj][1];
                    if (gate) {
#pragma unroll
                        for (int j = 0; j < 4; ++j) { v0[j] = sigm(v0[j]); v1[j] = sigm(v1[j]); } }
                    if (base != ZA) {
                        const float sc_ = gate ? 256.f : 16.f; int t0 = 0, t1 = 0;
                        t0 = __builtin_amdgcn_cvt_pk_fp8_f32(z448(v0[0] * sc_), z448(v0[1] * sc_), t0, false); t0 = __builtin_amdgcn_cvt_pk_fp8_f32(z448(v0[2] * sc_), z448(v0[3] * sc_), t0, true);
                        t1 = __builtin_amdgcn_cvt_pk_fp8_f32(z448(v1[0] * sc_), z448(v1[1] * sc_), t1, false); t1 = __builtin_amdgcn_cvt_pk_fp8_f32(z448(v1[2] * sc_), z448(v1[3] * sc_), t1, true);
                        zu32x2 w8; w8.x = (unsigned)t0; w8.y = (unsigned)t1;
                        *(zu32x2*)((unsigned char*)base + (size_t)(row0 + ai * HALF + m * 16) * ldc + col0 + bj * HALF) = w8;
                    } else {
                    u32x4 w; w.x = cvt_pk_bf16(v0[0], v0[1]); w.y = cvt_pk_bf16(v0[2], v0[3]); w.z = cvt_pk_bf16(v1[0], v1[1]); w.w = cvt_pk_bf16(v1[2], v1[3]);
                    *(u32x4*)(rowp + bj * HALF) = w; } } }
    }
};
template <int MODE> struct EpiAct {
    static constexpr bool PERM = true, AFTER_DRAIN = false;
    bf16_t* O; int ldc; const float* bias;
    __device__ __forceinline__ void operator()(const f32x4 (&acc)[2][2][4][2], const Unit& u, int wr, int wc, int fr, int fq) const {
        const int row0 = u.pm * BM + wr * 64 + fr, col0 = u.pn * BM + wc * 32 + 8 * fq;
#pragma unroll
        for (int ai = 0; ai < 2; ++ai)
#pragma unroll
            for (int m = 0; m < 4; ++m) { bf16_t* rowp = O + (size_t)(row0 + ai * HALF + m * 16) * ldc + col0;
#pragma unroll
                for (int bj = 0; bj < 2; ++bj) { f32x4 v0 = acc[ai][bj][m][0], v1 = acc[ai][bj][m][1];
                    if (MODE != 0) { v0 += *(const f32x4*)(bias + col0 + bj * HALF); v1 += *(const f32x4*)(bias + col0 + bj * HALF + 4); }
                    if (MODE != 0) {
#pragma unroll
                        for (int j = 0; j < 4; ++j) { v0[j] = sigm(v0[j]); v1[j] = sigm(v1[j]); if (MODE == 2) { v0[j] *= -0.60653066f; v1[j] *= -0.60653066f; } } }
                    u32x4 w; w.x = cvt_pk_bf16(v0[0], v0[1]); w.y = cvt_pk_bf16(v0[2], v0[3]); w.z = cvt_pk_bf16(v1[0], v1[1]); w.w = cvt_pk_bf16(v1[2], v1[3]);
                    *(u32x4*)(rowp + bj * HALF) = w; } }
    }
};
template <bool ADD> struct EpiGate {
    static constexpr bool PERM = true, AFTER_DRAIN = false;
    bf16_t* O; const bf16_t* G; int gcol; const bf16_t* T;
    __device__ __forceinline__ void operator()(const f32x4 (&acc)[2][2][4][2], const Unit& u, int wr, int wc, int fr, int fq) const {
        const int row0 = u.pm * BM + wr * 64 + fr, col0 = u.pn * BM + wc * 32 + 8 * fq;
#pragma unroll
        for (int ai = 0; ai < 2; ++ai)
#pragma unroll
            for (int m = 0; m < 4; ++m) { const size_t r = (size_t)(row0 + ai * HALF + m * 16);
#pragma unroll
                for (int bj = 0; bj < 2; ++bj) { const int c = col0 + bj * HALF;
                    const u32x4 g = *(const u32x4*)(G + r * 4096 + gcol + c);
                    f32x4 v0 = acc[ai][bj][m][0], v1 = acc[ai][bj][m][1];
                    v0[0] *= bflo(g.x); v0[1] *= bfhi(g.x); v0[2] *= bflo(g.y); v0[3] *= bfhi(g.y); v1[0] *= bflo(g.z); v1[1] *= bfhi(g.z); v1[2] *= bflo(g.w); v1[3] *= bfhi(g.w);
                    if (ADD) { const u32x4 t = *(const u32x4*)(T + r * 2048 + c);
                        v0[0] += bflo(t.x); v0[1] += bfhi(t.x); v0[2] += bflo(t.y); v0[3] += bfhi(t.y); v1[0] += bflo(t.z); v1[1] += bfhi(t.z); v1[2] += bflo(t.w); v1[3] += bfhi(t.w); }
                    u32x4 w; w.x = cvt_pk_bf16(v0[0], v0[1]); w.y = cvt_pk_bf16(v0[2], v0[3]); w.z = cvt_pk_bf16(v1[0], v1[1]); w.w = cvt_pk_bf16(v1[2], v1[3]);
                    *(u32x4*)(O + r * 2048 + c) = w; } }
    }
};
struct EpiRes {
    static constexpr bool PERM = false, AFTER_DRAIN = false;
    const float* X; float* OUT; const float* gate; int gstride;
    __device__ __forceinline__ void operator()(const f32x4 (&acc)[2][2][4][2], const Unit& u, int wr, int wc, int fr, int fq) const {
        const int row0 = u.pm * BM + wr * 64 + fr, col0 = u.pn * BM + wc * 32 + 4 * fq;
        const int b = (u.pm >= 32) ? 1 : 0;
        f32x4 gv[2][2];
#pragma unroll
        for (int bj = 0; bj < 2; ++bj)
#pragma unroll
            for (int n = 0; n < 2; ++n) gv[bj][n] = X ? *(const f32x4*)(gate + (size_t)b * gstride + col0 + bj * HALF + n * 16) : (f32x4){1.f, 1.f, 1.f, 1.f};
#pragma unroll
        for (int ai = 0; ai < 2; ++ai)
#pragma unroll
            for (int m = 0; m < 4; ++m) { const size_t off = (size_t)(row0 + ai * HALF + m * 16) * 2048 + col0;
#pragma unroll
                for (int bj = 0; bj < 2; ++bj)
#pragma unroll
                    for (int n = 0; n < 2; ++n) { f32x4 o = acc[ai][bj][m][n] * gv[bj][n];
                        if (X) o += *(const f32x4*)(X + off + bj * HALF + n * 16);
                        *(f32x4*)(OUT + off + bj * HALF + n * 16) = o; } }
    }
};
struct EpiLora {
    static constexpr bool PERM = true, AFTER_DRAIN = false;
    bf16_t* O[5]; const float* bias[5];
    __device__ __forceinline__ void operator()(const f32x4 (&acc)[2][2][4][2], const Unit& u, int wr, int wc, int fr, int fq) const {
        const int grp = u.pn >> 2, mode = (grp < 2) ? 2 : ((grp < 4) ? 1 : 0);
        const int row0 = u.pm * BM + wr * 64 + fr, col0 = (u.pn & 3) * BM + wc * 32 + 8 * fq;
        bf16_t* Og = O[0]; const float* bg = bias[0];
        if (grp == 1) { Og = O[1]; bg = bias[1]; } else if (grp == 2) { Og = O[2]; bg = bias[2]; } else if (grp == 3) { Og = O[3]; bg = bias[3]; } else if (grp == 4) { Og = O[4]; bg = bias[4]; }
#pragma unroll
        for (int ai = 0; ai < 2; ++ai)
#pragma unroll
            for (int m = 0; m < 4; ++m) { bf16_t* rowp = Og + (size_t)(row0 + ai * HALF + m * 16) * 1024 + col0;
#pragma unroll
                for (int bj = 0; bj < 2; ++bj) { f32x4 v0 = acc[ai][bj][m][0], v1 = acc[ai][bj][m][1];
                    if (mode != 0) { v0 += *(const f32x4*)(bg + col0 + bj * HALF); v1 += *(const f32x4*)(bg + col0 + bj * HALF + 4);
                        const float sc = (mode == 2) ? -0.60653066f : 1.0f;
#pragma unroll
                        for (int j = 0; j < 4; ++j) { v0[j] = sigm(v0[j]) * sc; v1[j] = sigm(v1[j]) * sc; } }
                    u32x4 w; w.x = cvt_pk_bf16(v0[0], v0[1]); w.y = cvt_pk_bf16(v0[2], v0[3]); w.z = cvt_pk_bf16(v1[0], v1[1]); w.w = cvt_pk_bf16(v1[2], v1[3]);
                    *(u32x4*)(rowp + bj * HALF) = w; } }
    }
};
typedef unsigned u32x2 __attribute__((ext_vector_type(2)));
__device__ __forceinline__ float c448(float x) { return __builtin_amdgcn_fmed3f(x, -448.f, 448.f); }
struct EpiGate2 {
    static constexpr bool PERM = true, AFTER_DRAIN = false;
    bf16_t* O; const bf16_t* G;
    __device__ __forceinline__ void mid(f32x4 (&acc)[2][2][4][2], const Unit& u, int wr, int wc, int fr, int fq) const {
        const int row0 = u.pm * BM + wr * 64 + fr, col0 = u.pn * BM + wc * 32 + 8 * fq;
        unsigned off = (unsigned)(row0 * 4096 + col0);
        const char* Gb = (const char*)G;
#pragma unroll
        for (int ai = 0; ai < 2; ++ai)
#pragma unroll
            for (int m = 0; m < 4; ++m) {
#pragma unroll
                for (int bj = 0; bj < 2; ++bj) {
                    asm volatile("" : "+v"(off));
                    const zu32x2 ga = *(const zu32x2*)(Gb + off + bj * 128), gb = *(const zu32x2*)(Gb + off + bj * 128 + 2048);
                    f32x4& v0 = acc[ai][bj][m][0]; f32x4& v1 = acc[ai][bj][m][1];
                    { const auto a0 = __builtin_amdgcn_cvt_pk_f32_fp8((int)ga.x, false), a1 = __builtin_amdgcn_cvt_pk_f32_fp8((int)ga.x, true), a2 = __builtin_amdgcn_cvt_pk_f32_fp8((int)ga.y, false), a3 = __builtin_amdgcn_cvt_pk_f32_fp8((int)ga.y, true);
                      const auto b0 = __builtin_amdgcn_cvt_pk_f32_fp8((int)gb.x, false), b1 = __builtin_amdgcn_cvt_pk_f32_fp8((int)gb.x, true), b2 = __builtin_amdgcn_cvt_pk_f32_fp8((int)gb.y, false), b3 = __builtin_amdgcn_cvt_pk_f32_fp8((int)gb.y, true);
                      v0[0] *= a0[0] * __builtin_amdgcn_rcpf(fmaxf(b0[0], 0.001953125f)); v0[1] *= a0[1] * __builtin_amdgcn_rcpf(fmaxf(b0[1], 0.001953125f)); v0[2] *= a1[0] * __builtin_amdgcn_rcpf(fmaxf(b1[0], 0.001953125f)); v0[3] *= a1[1] * __builtin_amdgcn_rcpf(fmaxf(b1[1], 0.001953125f));
                      v1[0] *= a2[0] * __builtin_amdgcn_rcpf(fmaxf(b2[0], 0.001953125f)); v1[1] *= a2[1] * __builtin_amdgcn_rcpf(fmaxf(b2[1], 0.001953125f)); v1[2] *= a3[0] * __builtin_amdgcn_rcpf(fmaxf(b3[0], 0.001953125f)); v1[3] *= a3[1] * __builtin_amdgcn_rcpf(fmaxf(b3[1], 0.001953125f)); }
                    asm volatile("" : "+v"(v0), "+v"(v1));
                }
                off += (m == 3) ? (unsigned)((HALF - 48) * 4096) : (unsigned)(16 * 4096);
            }
        __builtin_amdgcn_sched_barrier(0);
    }
    __device__ __forceinline__ void operator()(const f32x4 (&acc)[2][2][4][2], const Unit& u, int wr, int wc, int fr, int fq) const {
        const int row0 = u.pm * BM + wr * 64 + fr, col0 = u.pn * BM + wc * 32 + 8 * fq;
#pragma unroll
        for (int ai = 0; ai < 2; ++ai)
#pragma unroll
            for (int m = 0; m < 4; ++m) { const size_t r = (size_t)(row0 + ai * HALF + m * 16);
#pragma unroll
                for (int bj = 0; bj < 2; ++bj) { const int c = col0 + bj * HALF;
                    const zu32x2 g = *(const zu32x2*)((const unsigned char*)G + r * 4096 + 2048 + c);
                    f32x4 v0 = acc[ai][bj][m][0], v1 = acc[ai][bj][m][1];
                    { const auto g0 = __builtin_amdgcn_cvt_pk_f32_fp8((int)g.x, false), g1 = __builtin_amdgcn_cvt_pk_f32_fp8((int)g.x, true), g2 = __builtin_amdgcn_cvt_pk_f32_fp8((int)g.y, false), g3 = __builtin_amdgcn_cvt_pk_f32_fp8((int)g.y, true);
                      const float k_ = 1.0f / 256.0f;
                      v0[0] *= fmaxf(g0[0], 0.001953125f) * k_; v0[1] *= fmaxf(g0[1], 0.001953125f) * k_; v0[2] *= fmaxf(g1[0], 0.001953125f) * k_; v0[3] *= fmaxf(g1[1], 0.001953125f) * k_;
                      v1[0] *= fmaxf(g2[0], 0.001953125f) * k_; v1[1] *= fmaxf(g2[1], 0.001953125f) * k_; v1[2] *= fmaxf(g3[0], 0.001953125f) * k_; v1[3] *= fmaxf(g3[1], 0.001953125f) * k_; }
                    int t0 = 0, t1 = 0;
                    t0 = __builtin_amdgcn_cvt_pk_fp8_f32(c448(v0[0] * 32.f), c448(v0[1] * 32.f), t0, false); t0 = __builtin_amdgcn_cvt_pk_fp8_f32(c448(v0[2] * 32.f), c448(v0[3] * 32.f), t0, true);
                    t1 = __builtin_amdgcn_cvt_pk_fp8_f32(c448(v1[0] * 32.f), c448(v1[1] * 32.f), t1, false); t1 = __builtin_amdgcn_cvt_pk_fp8_f32(c448(v1[2] * 32.f), c448(v1[3] * 32.f), t1, true);
                    u32x2 w; w.x = (unsigned)t0; w.y = (unsigned)t1;
                    *(u32x2*)((unsigned char*)O + r * 2048 + c) = w; } }
    }
};
template <class Epi, class Sched, bool ALIGN_EPI = false, bool SP2 = false, bool DUALK = false, bool F8 = false>
__device__ __forceinline__ void gemm_phase(PG8_LAS unsigned char* lds, const Gemm g, const Sched& S, const Epi& E) {
    int tid_ = threadIdx.x; asm volatile("" : "+v"(tid_));
    const int tid = tid_, wid = __builtin_amdgcn_readfirstlane(tid >> 6), lane = tid & 63, wr = wid >> 2, wc = wid & 3, fr = lane & 15, fq = lane >> 4;
    const int K = DUALK ? g.K / 2 : g.K, nt = g.K / BK, nth = nt / 2;
    unsigned voffA[2], voffB[2];
#pragma unroll
    for (int i = 0; i < 2; ++i) { int R, C; stage_rc(tid * 16 + i * 8192, R, C); const int Rb = Epi::PERM ? ((R & ~31) + perm32(R & 31)) : R;
        voffA[i] = (unsigned)(R * K + C) * 2u; voffB[i] = (unsigned)(Rb * K + C) * 2u; }
    const size_t kstep = (size_t)(BK * 2);
    const size_t hstep = (size_t)HALF * K * 2;
    const size_t tstep = 2 * hstep;
    const unsigned ldsw = (unsigned)wid * 1024u;
    const int aoff = lds_byte(wr * 64 + fr, fq * 8), boff = lds_byte(wc * 32 + fr, fq * 8);
#define PG8_SA(b, h) (((b) * 2 + (h)) * HTB)
#define PG8_SB(b, h) ((4 + (b) * 2 + (h)) * HTB)
#define PG8_STAGE(bufoff, gbase, voff) do { _Pragma("unroll") for (int _i = 0; _i < 2; ++_i) \
        __builtin_amdgcn_global_load_lds((const unsigned*)((const char*)(gbase) + (voff)[_i]), (PG8_LAS unsigned*)(lds + (bufoff) + ldsw + _i * 8192), 16, 0, 0); } while (0)
#define PG8_LDA(dst, b, h) do { _Pragma("unroll") for (int m = 0; m < 4; ++m) { \
        if constexpr (F8) dst##8[m] = cat8(*(const PG8_LAS bf16x8*)(lds + PG8_SA(b, h) + aoff + m * 2048), *(const PG8_LAS bf16x8*)(lds + PG8_SA(b, h) + aoff + m * 2048 + 1024)); \
        else { _Pragma("unroll") for (int k = 0; k < 2; ++k) dst[m][k] = *(const PG8_LAS bf16x8*)(lds + PG8_SA(b, h) + aoff + m * 2048 + k * 1024); } } } while (0)
#define PG8_LDB(dst, b, h) do { _Pragma("unroll") for (int n = 0; n < 2; ++n) { \
        if constexpr (F8) dst##8[n] = cat8(*(const PG8_LAS bf16x8*)(lds + PG8_SB(b, h) + boff + n * 2048), *(const PG8_LAS bf16x8*)(lds + PG8_SB(b, h) + boff + n * 2048 + 1024)); \
        else { _Pragma("unroll") for (int k = 0; k < 2; ++k) dst[n][k] = *(const PG8_LAS bf16x8*)(lds + PG8_SB(b, h) + boff + n * 2048 + k * 1024); } } } while (0)
#define PG8_MMA(ai, bj, At, Bt) do { __builtin_amdgcn_s_setprio(1); _Pragma("unroll") for (int m = 0; m < 4; ++m) _Pragma("unroll") for (int n = 0; n < 2; ++n) { \
        if constexpr (F8) asm volatile("v_mfma_scale_f32_16x16x128_f8f6f4 %0, %1, %2, %0, %3, %4 op_sel_hi:[0,0,0]" : "+v"(acc[ai][bj][m][n]) : "v"(Bt##8[n]), "v"(At##8[m]), "v"(f8sb_), "v"(f8sa_));     \
        else { _Pragma("unroll") for (int k = 0; k < 2; ++k) acc[ai][bj][m][n] = __builtin_amdgcn_mfma_f32_16x16x32_bf16(Bt[n][k], At[m][k], acc[ai][bj][m][n], 0, 0, 0); } } __builtin_amdgcn_s_setprio(0); } while (0)
#define PG8_WAIT_V(n) asm volatile("s_waitcnt vmcnt(" #n ")" ::: "memory")
#define PG8_WAIT_L(n) asm volatile("s_waitcnt lgkmcnt(" #n ")" ::: "memory")
#define PG8_BAR __builtin_amdgcn_s_barrier()
#define PG8_SCHED __builtin_amdgcn_sched_barrier(0)
    Unit cur, nxt; int ui = 0;
    if (!S.next(0, cur)) return;
    f32x4 acc[2][2][4][2];
#pragma unroll
    for (int a = 0; a < 2; ++a)
#pragma unroll
        for (int b = 0; b < 2; ++b)
#pragma unroll
            for (int m = 0; m < 4; ++m)
#pragma unroll
                for (int n = 0; n < 2; ++n) acc[a][b][m][n] = (f32x4){0.f, 0.f, 0.f, 0.f};
    const unsigned f8sb_ = g.f8sb, f8sa_ = g.f8sa;
    bf16x8 At[4][2], B0[2][2], B1[2][2]; i32x8 At8[4], B08[2], B18[2];
    const char* cA = (const char*)g.A + S.a_off(cur) + (size_t)cur.pm * tstep; const char* cB = (const char*)g.Bt + (size_t)cur.pn * tstep;
    const char* cA2 = DUALK ? (const char*)g.A2 + (size_t)cur.pm * tstep : cA; const char* cB2 = DUALK ? (const char*)g.Bt2 + (size_t)cur.pn * tstep : cB;
#define PG8_TA(tt) ((DUALK && (tt) >= nth) ? cA2 + (size_t)((tt) - nth) * kstep : cA + (size_t)(tt) * kstep)
#define PG8_TB(tt) ((DUALK && (tt) >= nth) ? cB2 + (size_t)((tt) - nth) * kstep : cB + (size_t)(tt) * kstep)
    S.a_ready(cur);
    if constexpr (SP2) {
        PG8_STAGE(PG8_SB(0, 0), cB, voffB); PG8_STAGE(PG8_SB(0, 1), cB + hstep, voffB); PG8_STAGE(PG8_SA(0, 0), cA, voffA); PG8_STAGE(PG8_SA(0, 1), cA + hstep, voffA);
        if (wr == 1) PG8_BAR;
        PG8_WAIT_V(2); PG8_BAR;
        PG8_STAGE(PG8_SB(1, 0), cB + kstep, voffB); PG8_STAGE(PG8_SA(1, 0), cA + kstep, voffA); PG8_STAGE(PG8_SB(1, 1), cB + hstep + kstep, voffB);
        PG8_WAIT_V(6); PG8_BAR;
    } else {
        PG8_STAGE(PG8_SB(0, 0), cB, voffB); PG8_STAGE(PG8_SA(0, 0), cA, voffA); PG8_STAGE(PG8_SB(0, 1), cB + hstep, voffB); PG8_STAGE(PG8_SA(0, 1), cA + hstep, voffA);
        if (wr == 1) PG8_BAR;
        PG8_WAIT_V(4); PG8_BAR;
        PG8_STAGE(PG8_SB(1, 0), cB + kstep, voffB); PG8_STAGE(PG8_SA(1, 0), cA + kstep, voffA); PG8_STAGE(PG8_SB(1, 1), cB + hstep + kstep, voffB);
        PG8_WAIT_V(6); PG8_BAR;
    }
    for (;;) {
        const bool has_next = S.next(ui + 1, nxt);
        const char* nA = has_next ? (const char*)g.A + S.a_off(nxt) + (size_t)nxt.pm * tstep : cA; const char* nB = has_next ? (const char*)g.Bt + (size_t)nxt.pn * tstep : cB;
        const char* nA2 = (DUALK && has_next) ? (const char*)g.A2 + (size_t)nxt.pm * tstep : cA2; const char* nB2 = (DUALK && has_next) ? (const char*)g.Bt2 + (size_t)nxt.pn * tstep : cB2;
        for (int t = 0; t < nt; t += 2) {
            const bool last = (t == nt - 2);
            const char* a1 = PG8_TA(t + 1);
            const char* a2 = last ? nA : PG8_TA(t + 2); const char* b2 = last ? nB : PG8_TB(t + 2);
            if constexpr (DUALK) { if (t == nth) { if constexpr (F8) { asm volatile("s_nop 15\n\ts_nop 15" ::: "memory"); } E.mid(acc, cur, wr, wc, fr, fq); } }
            const char* a3 = a2 + kstep; const char* b3 = b2 + kstep;
            if (last && has_next) S.a_ready(nxt);
            if constexpr (SP2) {
            PG8_LDB(B0, 0, 0); PG8_LDB(B1, 0, 1); PG8_SCHED; PG8_LDA(At, 0, 0); PG8_STAGE(PG8_SA(1, 1), a1 + hstep, voffA);
            PG8_WAIT_V(8); PG8_WAIT_L(0); PG8_BAR; PG8_MMA(0, 0, At, B0); PG8_MMA(0, 1, At, B1); PG8_BAR; PG8_SCHED;
            PG8_LDA(At, 0, 1); PG8_STAGE(PG8_SB(0, 0), b2, voffB); PG8_STAGE(PG8_SB(0, 1), b2 + hstep, voffB); PG8_STAGE(PG8_SA(0, 0), a2, voffA);
            PG8_WAIT_V(8); PG8_WAIT_L(0); PG8_BAR; PG8_MMA(1, 0, At, B0); PG8_MMA(1, 1, At, B1); PG8_BAR; PG8_SCHED;
            PG8_LDB(B0, 1, 0); PG8_LDB(B1, 1, 1); PG8_SCHED; PG8_LDA(At, 1, 0); PG8_STAGE(PG8_SA(0, 1), a2 + hstep, voffA);
            PG8_WAIT_V(8); PG8_WAIT_L(0); PG8_BAR; PG8_MMA(0, 0, At, B0); PG8_MMA(0, 1, At, B1); PG8_BAR; PG8_SCHED;
            PG8_LDA(At, 1, 1); PG8_STAGE(PG8_SB(1, 0), b3, voffB); PG8_STAGE(PG8_SB(1, 1), b3 + hstep, voffB); PG8_STAGE(PG8_SA(1, 0), a3, voffA);
            PG8_WAIT_V(8); PG8_WAIT_L(0); PG8_BAR; PG8_MMA(1, 0, At, B0); PG8_MMA(1, 1, At, B1); PG8_BAR; PG8_SCHED;
            } else {
            PG8_LDB(B0, 0, 0); PG8_SCHED; PG8_LDA(At, 0, 0); PG8_STAGE(PG8_SA(1, 1), a1 + hstep, voffA);
            PG8_WAIT_L(8); PG8_BAR; PG8_WAIT_L(0); PG8_MMA(0, 0, At, B0); PG8_BAR; PG8_SCHED;
            PG8_LDB(B1, 0, 1); PG8_STAGE(PG8_SB(0, 0), b2, voffB);
            PG8_BAR; PG8_WAIT_L(0); PG8_MMA(0, 1, At, B1); PG8_BAR;
            PG8_LDA(At, 0, 1); PG8_STAGE(PG8_SA(0, 0), a2, voffA);
            PG8_BAR; PG8_WAIT_L(0); PG8_MMA(1, 0, At, B0); PG8_BAR; PG8_SCHED;
            PG8_STAGE(PG8_SB(0, 1), b2 + hstep, voffB);
            PG8_WAIT_V(6); PG8_BAR; PG8_MMA(1, 1, At, B1); PG8_BAR;
            PG8_LDB(B0, 1, 0); PG8_SCHED; PG8_LDA(At, 1, 0); PG8_STAGE(PG8_SA(0, 1), a2 + hstep, voffA);
            PG8_WAIT_L(8); PG8_BAR; PG8_WAIT_L(0); PG8_MMA(0, 0, At, B0); PG8_BAR; PG8_SCHED;
            PG8_LDB(B1, 1, 1); PG8_STAGE(PG8_SB(1, 0), b3, voffB);
            PG8_BAR; PG8_WAIT_L(0); PG8_MMA(0, 1, At, B1); PG8_BAR;
            PG8_LDA(At, 1, 1); PG8_STAGE(PG8_SA(1, 0), a3, voffA);
            PG8_BAR; PG8_WAIT_L(0); PG8_MMA(1, 0, At, B0); PG8_BAR; PG8_SCHED;
            PG8_STAGE(PG8_SB(1, 1), b3 + hstep, voffB);
            PG8_WAIT_V(6); PG8_BAR; PG8_MMA(1, 1, At, B1); PG8_BAR;
            }
        }
        if constexpr (ALIGN_EPI) { if (wr == 0) PG8_BAR; }
        if constexpr (F8) { asm volatile("s_nop 15\n\ts_nop 15" ::: "memory"); }
        if constexpr (!Epi::AFTER_DRAIN) { E(acc, cur, wr, wc, fr, fq); S.done(cur); }
        if (!has_next) break;
#pragma unroll
        for (int a = 0; a < 2; ++a)
#pragma unroll
            for (int b = 0; b < 2; ++b)
#pragma unroll
                for (int m = 0; m < 4; ++m)
#pragma unroll
                    for (int n = 0; n < 2; ++n) acc[a][b][m][n] = (f32x4){0.f, 0.f, 0.f, 0.f};
        cur = nxt; cA = nA; cB = nB; cA2 = nA2; cB2 = nB2; ++ui;
        if constexpr (ALIGN_EPI) { if (wr == 1) PG8_BAR; }
    }
    PG8_WAIT_V(0);
    if constexpr (!ALIGN_EPI) { if (wr == 0) PG8_BAR; }
    PG8_BAR;
    if constexpr (Epi::AFTER_DRAIN) { E.fused(acc, cur, wr, wc, fr, fq, lds, wid, lane); S.done(cur); }
#undef PG8_TA
#undef PG8_TB
#undef PG8_SA
#undef PG8_SB
#undef PG8_STAGE
#undef PG8_LDA
#undef PG8_LDB
#undef PG8_MMA
#undef PG8_WAIT_V
#undef PG8_WAIT_L
#undef PG8_BAR
#undef PG8_SCHED
}
}

constexpr int NWAVES = 8;
constexpr int DM = 2048, SEQ = 8192, MROWS = 16384;
constexpr int NZ = 11008;
constexpr int N_PHASES = 18;
constexpr size_t MiB = 1ull << 20;
constexpr size_t WS_CTL = 0, CTL_ZERO_BYTES = 1 * MiB;
constexpr int CW_BAR = 4096;
constexpr size_t WS_MOD = 256 * 1024;
constexpr size_t WS_LORA = 2 * MiB;
constexpr size_t WS_WA = 5 * MiB, WS_WB = 9 * MiB, WS_WOUT = 13 * MiB, WS_WQS = 21 * MiB;
constexpr size_t WS_WIN = 29 * MiB;
constexpr size_t WS_U16 = 72 * MiB;
constexpr size_t WS_ZA = 136 * MiB;
constexpr size_t WS_ZB = 232 * MiB;
constexpr size_t WS_R = 352 * MiB, WS_K = 384 * MiB, WS_V = 416 * MiB, WS_KK = 448 * MiB;
constexpr size_t WS_OA = 29 * MiB;
constexpr size_t WS_T = 72 * MiB;
constexpr size_t WS_LWF = 232 * MiB, WS_LWB = 264 * MiB, WS_ICF = 296 * MiB, WS_ICB = 512 * MiB, WS_G = 544 * MiB;
constexpr size_t WS_OF = 72 * MiB, WS_OBW = 104 * MiB;
constexpr size_t WS_OB16 = 296 * MiB;
constexpr size_t WS_TMPA = 352 * MiB, WS_MERGED = 416 * MiB;
constexpr size_t WS_U2 = 72 * MiB;
constexpr size_t WS_PU = 136 * MiB, WS_PV = 168 * MiB;
constexpr size_t WS_EIDX = 29 * MiB, WS_ESU = 37 * MiB, WS_EGV = 45 * MiB;
constexpr size_t WS_PSC = 200 * MiB;
constexpr size_t WS_HP = 264 * MiB;
constexpr size_t WS_GVP = 53 * MiB;
constexpr size_t WS_SC = 264 * MiB;
constexpr size_t WS_VT = 480 * MiB;
constexpr size_t WS_PHIF = 576 * MiB, WS_PHIB = 328 * MiB;
constexpr size_t WS_QS = 61 * MiB, WS_PS = 65 * MiB, WS_SST = 69 * MiB;
constexpr size_t WS_X8H = 416 * MiB, WS_X8L = 448 * MiB;
constexpr size_t WS_END = 600 * MiB;
constexpr int LDS_BYTES = 163840, MISC_OFF = 157696;

#define GAS __attribute__((address_space(1)))
#define LAS __attribute__((address_space(3)))
#define DI __device__ __forceinline__
typedef unsigned short bf16;
typedef unsigned v4u __attribute__((ext_vector_type(4)));
typedef unsigned v2u __attribute__((ext_vector_type(2)));
typedef float f32x4 __attribute__((ext_vector_type(4)));
#define LDS_WAIT() asm volatile("s_waitcnt lgkmcnt(0)" ::: "memory")
DI unsigned f2bf(float f) { unsigned u = __builtin_bit_cast(unsigned, f); return (u + 0x7fffu + ((u >> 16) & 1u)) >> 16; }
DI unsigned pk2(float lo, float hi) { return f2bf(lo) | (f2bf(hi) << 16); }
DI float bflo(unsigned u) { return __uint_as_float(u << 16); }
DI float bfhi(unsigned u) { return __uint_as_float(u & 0xffff0000u); }
DI float sigm(float x) { return 1.0f / (1.0f + __expf(-x)); }
DI float wave_sum(float v) {
#pragma unroll
    for (int o = 32; o >= 1; o >>= 1) v += __shfl_xor(v, o);
    return v;
}
DI float wave_max(float v) {
#pragma unroll
    for (int o = 32; o >= 1; o >>= 1) v = fmaxf(v, __shfl_xor(v, o));
    return v;
}
template <int CTRL> DI float dpp_mov(float v) { return __int_as_float(__builtin_amdgcn_update_dpp(0, __float_as_int(v), CTRL, 0xF, 0xF, false)); }
DI float row16_sum(float v) { v += dpp_mov<0xB1>(v); v += dpp_mov<0x4E>(v); v += dpp_mov<0x124>(v); v += dpp_mov<0x128>(v); return v; }
template <int CTRL> DI float dpp_maxf(float v) { return fmaxf(v, dpp_mov<CTRL>(v)); }
DI float row16_max(float v) { v = dpp_maxf<0xB1>(v); v = dpp_maxf<0x4E>(v); v = dpp_maxf<0x124>(v); v = dpp_maxf<0x128>(v); return v; }
DI float rdl(float v, int l) { return __uint_as_float(__builtin_amdgcn_readlane(__float_as_uint(v), l)); }
DI float wave_sum_fast(float v) { v = row16_sum(v); return (rdl(v, 0) + rdl(v, 16)) + (rdl(v, 32) + rdl(v, 48)); }
DI float wave_max_fast(float v) { v = row16_max(v); return fmaxf(fmaxf(rdl(v, 0), rdl(v, 16)), fmaxf(rdl(v, 32), rdl(v, 48))); }
typedef float f32x2 __attribute__((ext_vector_type(2)));
template <int CTRL> DI float dpp_addf(float v) { return v + dpp_mov<CTRL>(v); }
DI float group8_sum(float v) { v = dpp_addf<0xB1>(v); v = dpp_addf<0x4E>(v); v = dpp_addf<0x141>(v); return v; }
#define XB_TMO      128
#define XB_XCNT(j)  (256  + 64 * (j))
#define XB_XSUB(j)  (1280 + 64 * (j))
#define XB_XGEN(j)  (2304 + 64 * (j))
#define XB_TOP      3328
#define XB_TOPGEN   3392
#define XCD_BAR_WORDS 3456
#define XB_SPIN_CAP (1u << 18)

__device__ __forceinline__ unsigned xb_ld(unsigned* p)              { return __hip_atomic_load(p, __ATOMIC_RELAXED, __HIP_MEMORY_SCOPE_AGENT); }
__device__ __forceinline__ unsigned xb_add(unsigned* p, unsigned v) { return __hip_atomic_fetch_add(p, v, __ATOMIC_RELAXED, __HIP_MEMORY_SCOPE_AGENT); }
__device__ __forceinline__ unsigned xb_xcc_id() { return (unsigned)__builtin_amdgcn_s_getreg((3 << 11) | 20) & 0xFu; }
#define XB_SPIN(cond, bar) do { unsigned _sp = 0; while (cond) { __builtin_amdgcn_s_sleep(1); \
    if ((++_sp & 255u) == 0u) { if (xb_ld(&(bar)[XB_TMO])) break; if (_sp > XB_SPIN_CAP) { atomicAdd(&(bar)[XB_TMO], 1u); break; } } } } while (0)

struct XcdBarrier {
    unsigned* bar; unsigned x;
    volatile LAS unsigned* st;
};

__device__ __forceinline__ XcdBarrier xcd_barrier_post(unsigned* bar, volatile LAS unsigned* st) {
    XcdBarrier b; b.bar = bar; b.x = xb_xcc_id(); b.st = st;
    if (threadIdx.x == 0) (void)xb_add(&bar[XB_XCNT(b.x)], 1u);
    return b;
}
__device__ __forceinline__ void xcd_barrier_complete(unsigned* bar, unsigned x, unsigned& nloc, unsigned& nx) {
    const unsigned G = gridDim.x * gridDim.y * gridDim.z;
    unsigned sum, cnt, mine, sp = 0u;
    for (;;) {
        sum = 0u; cnt = 0u; mine = 0u;
#pragma unroll
        for (unsigned j = 0; j < 16; ++j) { const unsigned c = xb_ld(&bar[XB_XCNT(j)]); sum += c; cnt += (c > 0u) ? 1u : 0u; mine = (j == x) ? c : mine; }
        if (sum == G) break;
        __builtin_amdgcn_s_sleep(1);
        if ((++sp & 255u) == 0u) { if (xb_ld(&bar[XB_TMO])) break; if (sp > XB_SPIN_CAP) { atomicAdd(&bar[XB_TMO], 1u); break; } }
    }
    nloc = mine > 0u ? mine : 1u; nx = cnt > 0u ? cnt : 1u;
}

__device__ __forceinline__ void xcd_barrier(const XcdBarrier& b) {
    asm volatile("s_waitcnt vmcnt(0)" ::: "memory");
    __syncthreads();
    if (threadIdx.x == 0) {
        unsigned* bar = b.bar;
        __builtin_amdgcn_s_waitcnt(0);
        unsigned nloc = b.st[0], nx = b.st[1];
        if (nloc == 0u) { xcd_barrier_complete(bar, b.x, nloc, nx); b.st[0] = nloc; b.st[1] = nx; }
        const unsigned old = xb_add(&bar[XB_XSUB(b.x)], 1u);
        const unsigned gen = old / nloc;
        if (old + 1u == (gen + 1u) * nloc) {
            __builtin_amdgcn_fence(__ATOMIC_RELEASE, "agent");
            asm volatile("s_waitcnt vmcnt(0)" ::: "memory");
            const unsigned og = xb_add(&bar[XB_TOP], 1u);
            const unsigned tg = og / nx;
            if (og + 1u == (tg + 1u) * nx) xb_add(&bar[XB_TOPGEN], 1u);
            else XB_SPIN(xb_ld(&bar[XB_TOPGEN]) == tg, bar);
            __builtin_amdgcn_fence(__ATOMIC_ACQUIRE, "agent");
            xb_add(&bar[XB_XGEN(b.x)], 1u);
            asm volatile("s_waitcnt vmcnt(0)" ::: "memory");
        } else {
            XB_SPIN(xb_ld(&bar[XB_XGEN(b.x)]) == gen, bar);
            __builtin_amdgcn_fence(__ATOMIC_ACQUIRE, "agent");
            asm volatile("s_waitcnt vmcnt(0)" ::: "memory");
        }
    }
    __syncthreads();
}

struct Args { const float* in[30]; float* out; unsigned char* ws; int ph_lo, ph_hi; };
struct Ctx { LAS unsigned char* lds; int tid, lane, wave, bid, G, gw, NGW; };

DI float c448(float x) { return __builtin_amdgcn_fmed3f(x, -448.f, 448.f); }
DI void p0_transpose_item(const float* W, int K, int N, bf16* WT, int pad_from, int pad_rows, LAS float* scr, int item, int lane, float qs = 0.f) {
    const int nblk = N / 64, kb = item / nblk, nb = item % nblk, k0 = 64 * kb, n0 = 64 * nb;
    const int row_off = (n0 >= pad_from) ? pad_rows : 0;
    const int kr = lane >> 4, n4 = (lane & 15) * 4;
    f32x4 v[16];
#pragma unroll
    for (int i = 0; i < 16; ++i) v[i] = *(const f32x4*)(W + (size_t)(k0 + 4 * i + kr) * N + n0 + n4);
#pragma unroll
    for (int i = 0; i < 16; ++i) { LAS float* d = scr + (4 * i + kr) * 65 + n4; d[0] = v[i].x; d[1] = v[i].y; d[2] = v[i].z; d[3] = v[i].w; }
    LDS_WAIT(); asm volatile("" ::: "memory");
    const int kc = lane & 7, nr = lane >> 3;
#pragma unroll
    for (int j = 0; j < 8; ++j) { const int n = nr + 8 * j; const LAS float* sp = scr + (8 * kc) * 65 + n;
        if (qs != 0.f) { int t0 = 0, t1 = 0;
            t0 = __builtin_amdgcn_cvt_pk_fp8_f32(c448(sp[0 * 65] * qs), c448(sp[1 * 65] * qs), t0, false); t0 = __builtin_amdgcn_cvt_pk_fp8_f32(c448(sp[2 * 65] * qs), c448(sp[3 * 65] * qs), t0, true);
            t1 = __builtin_amdgcn_cvt_pk_fp8_f32(c448(sp[4 * 65] * qs), c448(sp[5 * 65] * qs), t1, false); t1 = __builtin_amdgcn_cvt_pk_fp8_f32(c448(sp[6 * 65] * qs), c448(sp[7 * 65] * qs), t1, true);
            v2u o; o.x = (unsigned)t0; o.y = (unsigned)t1;
            *(GAS v2u*)((unsigned char*)WT + (size_t)(row_off + n0 + n) * K + k0 + 8 * kc) = o; }
        else {
        v4u o; o.x = pk2(sp[0 * 65], sp[1 * 65]); o.y = pk2(sp[2 * 65], sp[3 * 65]); o.z = pk2(sp[4 * 65], sp[5 * 65]); o.w = pk2(sp[6 * 65], sp[7 * 65]);
        *(GAS v4u*)(WT + (size_t)(row_off + n0 + n) * K + k0 + 8 * kc) = o; } }
    LDS_WAIT(); asm volatile("" ::: "memory");
}
DI void phase_prologue(const Args& a, const Ctx& c) {
    unsigned char* ws = a.ws;
    {
        LAS float* scr = (LAS float*)(c.lds + c.wave * 16640);
        constexpr int I_IN = 32 * 170, I_A = 16 * 32, I_O = 32 * 32;
        for (int it = c.gw; it < I_IN + 2 * I_A + I_O; it += c.NGW) {
            int r = it;
            if (r < I_IN) { p0_transpose_item(a.in[6], 2048, 10880, (bf16*)(ws + WS_WIN), 6784, 128, scr, r, c.lane, 1024.f); continue; } r -= I_IN;
            if (r < I_A) { p0_transpose_item(a.in[22], 1024, 2048, (bf16*)(ws + WS_WA), 1 << 30, 0, scr, r, c.lane, 512.f); continue; } r -= I_A;
            if (r < I_A) { p0_transpose_item(a.in[23], 1024, 2048, (bf16*)(ws + WS_WB), 1 << 30, 0, scr, r, c.lane, 512.f); continue; } r -= I_A;
            p0_transpose_item(a.in[24], 2048, 2048, (bf16*)(ws + WS_WOUT), 1 << 30, 0, scr, r, c.lane, 1024.f);
        }
    }
    const int gt = c.bid * 512 + c.tid, NGT = c.G * 512;
    for (int i = gt; i < 128 * 2048 / 16; i += NGT) *(GAS v4u*)(ws + WS_WIN + (size_t)6784 * 2048 + (size_t)i * 16) = (v4u){0u, 0u, 0u, 0u};
    for (int ch = gt; ch < 5 * 1024 * 32; ch += NGT) {
        const int g = ch >> 15, n = (ch >> 5) & 1023, k0 = (ch & 31) * 8;
        float v[8];
#pragma unroll
        for (int e = 0; e < 8; ++e) { const int k = k0 + e; float x = 0.f;
            if (g < 2) { if (k < 96) x = a.in[13][(size_t)(g * 96 + k) * 1024 + n]; }
            else if (g < 4) { if (k < 96) x = a.in[15][(size_t)((g - 2) * 96 + k) * 1024 + n]; }
            else x = a.in[16][(size_t)k * 1024 + n];
            v[e] = x; }
        v4u o; o.x = pk2(v[0], v[1]); o.y = pk2(v[2], v[3]); o.z = pk2(v[4], v[5]); o.w = pk2(v[6], v[7]);
        *(GAS v4u*)((bf16*)(ws + WS_LORA) + (size_t)g * 1024 * 256 + (size_t)n * 256 + k0) = o;
    }
    __syncthreads();
    {
        LAS float* subl = (LAS float*)c.lds;
        LAS float* wql = (LAS float*)(c.lds + 66048);
        const int n = c.tid & 127, mg = c.tid >> 7;
        int cur_half = -1;
        for (int item = c.bid; item < 1024; item += c.G) {
            const int seg = item >> 6, mblk = item & 63, half = seg & 1;
            if (half != cur_half) {
                __syncthreads();
                const float* sub = half ? a.in[27] : a.in[26];
                for (int i = 0; i < 32; ++i) { const int idx = c.tid + 512 * i; subl[(idx >> 7) * 129 + (idx & 127)] = sub[idx]; }
                cur_half = half;
            }
            for (int i = 0; i < 8; ++i) { const int idx = c.tid + 512 * i; wql[idx] = a.in[25][(size_t)(mblk * 32 + (idx >> 7)) * 2048 + seg * 128 + (idx & 127)]; }
            __syncthreads();
            float acc[8];
#pragma unroll
            for (int j = 0; j < 8; ++j) acc[j] = 0.f;
            for (int d = 0; d < 128; d += 4) {
                const float s0 = subl[n * 129 + d], s1 = subl[n * 129 + d + 1], s2 = subl[n * 129 + d + 2], s3 = subl[n * 129 + d + 3];
#pragma unroll
                for (int j = 0; j < 8; ++j) { const f32x4 w = *(const LAS f32x4*)(wql + (mg * 8 + j) * 128 + d); acc[j] += s0 * w.x + s1 * w.y + s2 * w.z + s3 * w.w; }
            }
            v4u o; o.x = pk2(acc[0], acc[1]); o.y = pk2(acc[2], acc[3]); o.z = pk2(acc[4], acc[5]); o.w = pk2(acc[6], acc[7]);
            *(GAS v4u*)((bf16*)(ws + WS_WQS) + (size_t)(seg * 128 + n) * 2048 + mblk * 32 + mg * 8) = o;
            __syncthreads();
        }
    }
    {
        float* mod = (float*)(ws + WS_MOD);
        LAS float* red = (LAS float*)c.lds;
        const int c4 = c.tid & 15, kg = c.tid >> 4;
        for (int sl = c.bid; sl < 192; sl += c.G) {
            const float* wp = a.in[2] + sl * 64 + c4 * 4;
            f32x4 a0 = (f32x4){0.f, 0.f, 0.f, 0.f}, a1 = a0;
#pragma unroll 8
            for (int i = 0; i < 64; ++i) { const int k = kg + 32 * i;
                const float c0 = a.in[1][k], c1 = a.in[1][2048 + k];
                const float s0 = c0 * sigm(c0), s1 = c1 * sigm(c1);
                const f32x4 w = *(const f32x4*)(wp + (size_t)k * 12288);
                a0 += w * s0; a1 += w * s1; }
            __syncthreads();
            *(LAS f32x4*)(red + (kg * 16 + c4) * 8) = a0; *(LAS f32x4*)(red + (kg * 16 + c4) * 8 + 4) = a1;
            __syncthreads();
            if (c.tid < 128) { const int q = c.tid >> 3, j = c.tid & 7; float sum = 0.f;
                for (int g = 0; g < 32; ++g) sum += red[(g * 16 + q) * 8 + j];
                const int col = sl * 64 + q * 4 + (j & 3);
                mod[(size_t)(j >> 2) * 12288 + col] = sum + a.in[3][col]; }
            __syncthreads();
        }
    }
}

template <bool Q8> DI void phase_norm_mod(const Ctx& c, const float* x, const float* nw, const float* mod, int shift_off, int scale_off, bf16* dst) {
    for (int rp = c.gw; rp < MROWS / 2; rp += c.NGW) {
        const int b = (2 * rp) >> 13;
        f32x4 v[2][8]; float ss[2];
#pragma unroll
        for (int z = 0; z < 2; ++z) { const f32x4* xr = (const f32x4*)(x + (size_t)(2 * rp + z) * DM) + c.lane;
#pragma unroll
            for (int j = 0; j < 8; ++j) v[z][j] = xr[64 * j]; }
#pragma unroll
        for (int z = 0; z < 2; ++z) { float q = 0.f;
#pragma unroll
            for (int j = 0; j < 8; ++j) q += (v[z][j].x * v[z][j].x + v[z][j].y * v[z][j].y) + (v[z][j].z * v[z][j].z + v[z][j].w * v[z][j].w);
            ss[z] = rsqrtf(wave_sum_fast(q) * (1.0f / DM) + 1e-6f); }
        const f32x4* wv = (const f32x4*)nw + c.lane;
        const f32x4* sh = (const f32x4*)(mod + (size_t)b * 12288 + shift_off) + c.lane;
        const f32x4* sc = (const f32x4*)(mod + (size_t)b * 12288 + scale_off) + c.lane;
#pragma unroll
        for (int j = 0; j < 8; ++j) { const f32x4 w = wv[64 * j], s = sh[64 * j], g = sc[64 * j];
#pragma unroll
            for (int z = 0; z < 2; ++z) { const f32x4 y = (v[z][j] * ss[z]) * w * (g + 1.0f) + s;
                if (Q8) { int t = 0; t = __builtin_amdgcn_cvt_pk_fp8_f32(c448(y.x * 8.f), c448(y.y * 8.f), t, false); t = __builtin_amdgcn_cvt_pk_fp8_f32(c448(y.z * 8.f), c448(y.w * 8.f), t, true);
                    ((unsigned*)((unsigned char*)dst + (size_t)(2 * rp + z) * DM) + c.lane)[64 * j] = (unsigned)t; }
                else { v2u p; p.x = pk2(y.x, y.y); p.y = pk2(y.z, y.w); ((v2u*)(dst + (size_t)(2 * rp + z) * DM) + c.lane)[64 * j] = p; } } }
    }
}

DI void phase_qknorm_prep(const Args& a, const Ctx& c) {
    unsigned char* ws = a.ws;
    bf16* ZA = (bf16*)(ws + WS_ZA); const bf16* ZB = (const bf16*)(ws + WS_ZB);
    bf16* R16 = (bf16*)(ws + WS_R); bf16* K16 = (bf16*)(ws + WS_K); bf16* V16 = (bf16*)(ws + WS_V); bf16* KK16 = (bf16*)(ws + WS_KK);
    bf16* T = (bf16*)(ws + WS_T);
    const float* mu0 = a.in[11]; const float* mu1 = a.in[11] + 3712;
    for (int row = c.gw; row < MROWS; row += c.NGW) {
        {
            bf16* zr = ZA + (size_t)row * 3072;
#pragma unroll
            for (int cc = 0; cc < 4; ++cc) {
                const int col = cc * 512 + c.lane * 8;
                const v4u u = *(const v4u*)(zr + col);
                float v[8] = {bflo(u.x), bfhi(u.x), bflo(u.y), bfhi(u.y), bflo(u.z), bfhi(u.z), bflo(u.w), bfhi(u.w)};
                float ss = 0.f;
#pragma unroll
                for (int e = 0; e < 8; ++e) ss += v[e] * v[e];
                ss += __shfl_xor(ss, 1); ss += __shfl_xor(ss, 2); ss += __shfl_xor(ss, 4); ss += __shfl_xor(ss, 8);
                const bool isq = cc < 2;
                const float rstd = rsqrtf(ss * (1.0f / 128.0f) + 1e-6f) * (isq ? 0.08838834764831845f : 1.0f);
                const float* wn = (isq ? a.in[8] : a.in[9]) + (c.lane & 15) * 8;
#pragma unroll
                for (int e = 0; e < 8; ++e) v[e] = v[e] * rstd * wn[e];
                v4u o; o.x = pk2(v[0], v[1]); o.y = pk2(v[2], v[3]); o.z = pk2(v[4], v[5]); o.w = pk2(v[6], v[7]);
                *(v4u*)(zr + col) = o;
            }
        }
        {
            const int t = row & (SEQ - 1);
            const bool hp = t > 0, hn = t < SEQ - 1;
            const unsigned char* zc = (const unsigned char*)ZB + (size_t)row * 3840;
#pragma unroll
            for (int p = 0; p < 4; ++p) {
                const bool act = (p < 3) || (c.lane < 40);
                const int col = act ? (p * 1024 + c.lane * 16) : 0;
                const v4u uc = *(const v4u*)(zc + col);
                v4u up = (v4u){0u, 0u, 0u, 0u}, un = up;
                if (hp) up = *(const v4u*)(zc - 3840 + col);
                if (hn) un = *(const v4u*)(zc + 3840 + col);
                const unsigned wc4[4] = {uc.x, uc.y, uc.z, uc.w}, wp4[4] = {up.x, up.y, up.z, up.w}, wn4[4] = {un.x, un.y, un.z, un.w};
                float zs[16];
#pragma unroll
                for (int q = 0; q < 4; ++q) {
                    const f32x4 m0 = *(const f32x4*)(mu0 + col + 4 * q), m1 = *(const f32x4*)(mu1 + col + 4 * q);
                    const f32x2 c0 = __builtin_amdgcn_cvt_pk_f32_fp8((int)wc4[q], false), c1 = __builtin_amdgcn_cvt_pk_f32_fp8((int)wc4[q], true);
                    const f32x2 p0 = __builtin_amdgcn_cvt_pk_f32_fp8((int)wp4[q], false), p1 = __builtin_amdgcn_cvt_pk_f32_fp8((int)wp4[q], true);
                    const f32x2 n0 = __builtin_amdgcn_cvt_pk_f32_fp8((int)wn4[q], false), n1 = __builtin_amdgcn_cvt_pk_f32_fp8((int)wn4[q], true);
                    zs[4 * q] = (c0.x + m0.x * (p0.x - c0.x) + m1.x * (n0.x - c0.x)) * 0.0625f; zs[4 * q + 1] = (c0.y + m0.y * (p0.y - c0.y) + m1.y * (n0.y - c0.y)) * 0.0625f;
                    zs[4 * q + 2] = (c1.x + m0.z * (p1.x - c1.x) + m1.z * (n1.x - c1.x)) * 0.0625f; zs[4 * q + 3] = (c1.y + m0.w * (p1.y - c1.y) + m1.w * (n1.y - c1.y)) * 0.0625f;
                }
                v4u o0, o1;
                o0.x = pk2(zs[0], zs[1]); o0.y = pk2(zs[2], zs[3]); o0.z = pk2(zs[4], zs[5]); o0.w = pk2(zs[6], zs[7]); o1.x = pk2(zs[8], zs[9]); o1.y = pk2(zs[10], zs[11]); o1.z = pk2(zs[12], zs[13]); o1.w = pk2(zs[14], zs[15]);
                if (p == 0) { *(v4u*)(R16 + (size_t)row * 1024 + col) = o0; *(v4u*)(R16 + (size_t)row * 1024 + col + 8) = o1; }
                else if (p == 1) {
                    const int kc = col - 1024;
                    *(v4u*)(K16 + (size_t)row * 1024 + kc) = o0; *(v4u*)(K16 + (size_t)row * 1024 + kc + 8) = o1;
                    float kx[16]; float ss = 0.f;
#pragma unroll
                    for (int q = 0; q < 4; ++q) { const f32x4 ka = *(const f32x4*)(a.in[17] + kc + 4 * q);
                        kx[4 * q] = zs[4 * q] * ka.x; kx[4 * q + 1] = zs[4 * q + 1] * ka.y; kx[4 * q + 2] = zs[4 * q + 2] * ka.z; kx[4 * q + 3] = zs[4 * q + 3] * ka.w; }
#pragma unroll
                    for (int e = 0; e < 16; ++e) ss += kx[e] * kx[e];
                    ss += __shfl_xor(ss, 1); ss += __shfl_xor(ss, 2);
                    const float inv = 1.0f / fmaxf(sqrtf(ss), 1e-12f);
                    v4u q0, q1;
                    q0.x = pk2(kx[0] * inv, kx[1] * inv); q0.y = pk2(kx[2] * inv, kx[3] * inv); q0.z = pk2(kx[4] * inv, kx[5] * inv); q0.w = pk2(kx[6] * inv, kx[7] * inv);
                    q1.x = pk2(kx[8] * inv, kx[9] * inv); q1.y = pk2(kx[10] * inv, kx[11] * inv); q1.z = pk2(kx[12] * inv, kx[13] * inv); q1.w = pk2(kx[14] * inv, kx[15] * inv);
                    *(v4u*)(KK16 + (size_t)row * 1024 + kc) = q0; *(v4u*)(KK16 + (size_t)row * 1024 + kc + 8) = q1;
                } else if (p == 2) { *(v4u*)(V16 + (size_t)row * 1024 + (col - 2048)) = o0; *(v4u*)(V16 + (size_t)row * 1024 + (col - 2048) + 8) = o1; }
                else if (act) {
                    const int off = col - 3072;
                    int buf, k;
                    if (off < 96) { buf = 0; k = off; } else if (off < 192) { buf = 1; k = off - 96; } else if (off < 288) { buf = 2; k = off - 192; } else if (off < 384) { buf = 3; k = off - 288; } else { buf = 4; k = off - 384; }
                    float y[16];
#pragma unroll
                    for (int e = 0; e < 16; ++e) y[e] = (buf < 2) ? tanhf(zs[e]) : ((buf == 4) ? sigm(zs[e]) : zs[e]);
                    v4u t0, t1;
                    t0.x = pk2(y[0], y[1]); t0.y = pk2(y[2], y[3]); t0.z = pk2(y[4], y[5]); t0.w = pk2(y[6], y[7]); t1.x = pk2(y[8], y[9]); t1.y = pk2(y[10], y[11]); t1.z = pk2(y[12], y[13]); t1.w = pk2(y[14], y[15]);
                    bf16* tp = T + (size_t)buf * MROWS * 256 + (size_t)row * 256 + k;
                    *(v4u*)tp = t0; *(v4u*)(tp + 8) = t1;
                }
            }
            for (int i = c.lane; i < 80; i += 64) { const int buf = i / 20, chk = 12 + i % 20;
                *(v4u*)(T + (size_t)buf * MROWS * 256 + (size_t)row * 256 + chk * 8) = (v4u){0u, 0u, 0u, 0u}; }
        }
    }
}

DI void phase_vtranspose(const Args& a, const Ctx& c) {
    const bf16* ZA = (const bf16*)(a.ws + WS_ZA); bf16* VT = (bf16*)(a.ws + WS_VT);
    LAS bf16* tile = (LAS bf16*)(c.lds + c.wave * 9216);
    for (int item = c.gw; item < 256 * 16; item += c.NGW) {
        const int t0 = (item >> 4) * 64, c0 = (item & 15) * 64;
#pragma unroll
        for (int ch = 0; ch < 8; ++ch) *(LAS v4u*)(tile + c.lane * 72 + 8 * ch) = *(const v4u*)(ZA + (size_t)(t0 + c.lane) * 3072 + 2048 + c0 + 8 * ch);
        LDS_WAIT(); asm volatile("" ::: "memory");
        const int cg = c0 + c.lane, b = t0 >> 13, pos0 = t0 & (SEQ - 1);
        bf16* dst = VT + ((size_t)(b * 8 + (cg >> 7)) * 128 + (cg & 127)) * SEQ + pos0;
#pragma unroll
        for (int j = 0; j < 8; ++j) { unsigned e[8];
#pragma unroll
            for (int q = 0; q < 8; ++q) e[q] = tile[(8 * j + q) * 72 + c.lane];
            v4u o; o.x = e[0] | (e[1] << 16); o.y = e[2] | (e[3] << 16); o.z = e[4] | (e[5] << 16); o.w = e[6] | (e[7] << 16);
            *(v4u*)(dst + 8 * j) = o; }
        LDS_WAIT(); asm volatile("" ::: "memory");
    }
}

typedef short bf16x8 __attribute__((ext_vector_type(8)));
struct NaTask { int b, h, i, cq; };
DI void na_part_a(const bf16* ZA, const LAS float* rpbl, int lane, const NaTask t, int half, f32x4 (&S)[8][2], bf16x8 (&pf)[8], float& inv) {
    const int l15 = lane & 15, q4 = lane >> 4, b = t.b, h = t.h, i = t.i, cq = t.cq;
    const int wsc = min(max(16 * cq - 8, 0), 32);
    const int jq = 16 * cq + l15, cs = min(max(jq - 8, 0), 48);
    const int rs = min(max(i - 4, 0), 120);
    const size_t qtok = (size_t)b * SEQ + i * 64 + jq;
    bf16x8 qf[4];
#pragma unroll
    for (int ks = 0; ks < 4; ++ks) qf[ks] = *(const bf16x8*)(ZA + qtok * 3072 + h * 128 + 32 * ks + 8 * q4);
#pragma unroll
    for (int rh = 0; rh < 4; ++rh) {
        if ((rh >> 1) == half) {
        bf16x8 kf[4][4];
#pragma unroll
        for (int tt = 0; tt < 4; ++tt) { const int r = 2 * rh + (tt >> 1), u = tt & 1;
            const int kcol = wsc + 8 * (l15 >> 2) + 4 * u + (l15 & 3);
            const bf16* kp = ZA + ((size_t)b * SEQ + (rs + r) * 64 + kcol) * 3072 + 1024 + h * 128 + 8 * q4;
#pragma unroll
            for (int ks = 0; ks < 4; ++ks) kf[tt][ks] = *(const bf16x8*)(kp + 32 * ks); }
        __builtin_amdgcn_sched_barrier(0);
#pragma unroll
        for (int tt = 0; tt < 4; ++tt) { f32x4 acc = (f32x4){0.f, 0.f, 0.f, 0.f};
#pragma unroll
            for (int ks = 0; ks < 4; ++ks) acc = __builtin_amdgcn_mfma_f32_16x16x32_bf16(kf[tt][ks], qf[ks], acc, 0, 0, 0);
            S[2 * rh + (tt >> 1)][tt & 1] = acc; }
        }
    }
    if (half == 0) return;
    float mx = -1e30f;
#pragma unroll
    for (int r = 0; r < 8; ++r)
#pragma unroll
        for (int u = 0; u < 2; ++u)
#pragma unroll
            for (int j = 0; j < 4; ++j) {
                const int kc = wsc + 8 * q4 + 4 * u + j;
                const bool valid = (kc >= cs) && (kc < cs + 16);
                const int bi = valid ? ((rs + r - i + 7) * 31 + (kc - jq + 15)) : 0;
                const float sv = valid ? (S[r][u][j] + rpbl[bi]) : -1e30f;
                S[r][u][j] = sv; mx = fmaxf(mx, sv);
            }
    mx = fmaxf(mx, __shfl_xor(mx, 16)); mx = fmaxf(mx, __shfl_xor(mx, 32));
    float sum = 0.f;
#pragma unroll
    for (int r = 0; r < 8; ++r)
#pragma unroll
        for (int u = 0; u < 2; ++u)
#pragma unroll
            for (int j = 0; j < 4; ++j) { const float p = __expf(S[r][u][j] - mx); S[r][u][j] = p; sum += p; }
    sum += __shfl_xor(sum, 16); sum += __shfl_xor(sum, 32);
    inv = 1.0f / sum;
#pragma unroll
    for (int r = 0; r < 8; ++r) { v4u w; w.x = pk2(S[r][0][0], S[r][0][1]); w.y = pk2(S[r][0][2], S[r][0][3]); w.z = pk2(S[r][1][0], S[r][1][1]); w.w = pk2(S[r][1][2], S[r][1][3]);
        pf[r] = __builtin_bit_cast(bf16x8, w); }
}
DI void na_part_b(const bf16* VT, bf16* OA, int lane, const NaTask t, int half, const bf16x8 (&pf)[8], float inv) {
    const int l15 = lane & 15, q4 = lane >> 4, b = t.b, h = t.h, i = t.i, cq = t.cq;
    const int wsc = min(max(16 * cq - 8, 0), 32);
    const int rs = min(max(i - 4, 0), 120);
    const size_t qtok = (size_t)b * SEQ + i * 64 + 16 * cq + l15;
#pragma unroll
    for (int dh = 0; dh < 4; ++dh) {
        if ((dh >> 1) == half) {
        bf16x8 vf[2][8];
#pragma unroll
        for (int d4 = 0; d4 < 2; ++d4) { const int dt = 2 * dh + d4;
            const bf16* vp = VT + ((size_t)(b * 8 + h) * 128 + 16 * dt + l15) * SEQ + rs * 64 + wsc + 8 * q4;
#pragma unroll
            for (int r = 0; r < 8; ++r) vf[d4][r] = *(const bf16x8*)(vp + r * 64); }
        __builtin_amdgcn_sched_barrier(0);
#pragma unroll
        for (int d4 = 0; d4 < 2; ++d4) { const int dt = 2 * dh + d4;
            f32x4 o = (f32x4){0.f, 0.f, 0.f, 0.f};
#pragma unroll
            for (int r = 0; r < 8; ++r) o = __builtin_amdgcn_mfma_f32_16x16x32_bf16(vf[d4][r], pf[r], o, 0, 0, 0);
            const float i16 = inv * 16.f; int w = 0; w = __builtin_amdgcn_cvt_pk_fp8_f32(c448(o[0] * i16), c448(o[1] * i16), w, false); w = __builtin_amdgcn_cvt_pk_fp8_f32(c448(o[2] * i16), c448(o[3] * i16), w, true);
            *(int*)((unsigned char*)OA + qtok * 1024 + h * 128 + 16 * dt + 4 * q4) = w; }
        }
    }
}

DI void phase_na_attention(const Args& a, const Ctx& c) {
    const bf16* ZA = (const bf16*)(a.ws + WS_ZA); const bf16* VT = (const bf16*)(a.ws + WS_VT); bf16* OA = (bf16*)(a.ws + WS_OA);
    LAS float* rpbl = (LAS float*)c.lds;
    for (int blk = c.bid; blk < 256; blk += c.G) {
        const int b = blk >> 7, h = (blk >> 4) & 7, i0 = ((blk & 15) * 2 + 1) * 4;
        __syncthreads();
        for (int t = c.tid; t < 465; t += 512) rpbl[t] = a.in[10][h * 465 + t];
        __syncthreads();
        const int l15 = c.lane & 15, q4 = c.lane >> 4, cq = c.wave & 3;
        const int wsc = min(max(16 * cq - 8, 0), 32);
        const int jq = 16 * cq + l15, cs = min(max(jq - 8, 0), 48);
#pragma unroll 1
        for (int k = 0; k < 2; ++k) {
            const int i = i0 + 2 * k + (c.wave >> 2);
            const int rs = min(max(i - 4, 0), 120);
            const size_t qtok = (size_t)b * SEQ + i * 64 + jq;
            bf16x8 qf[4];
#pragma unroll
            for (int ks = 0; ks < 4; ++ks) qf[ks] = *(const bf16x8*)(ZA + qtok * 3072 + h * 128 + 32 * ks + 8 * q4);
            f32x4 S[8][2];
#pragma unroll
            for (int rh = 0; rh < 2; ++rh) {
                bf16x8 kf[8][4];
#pragma unroll
                for (int t = 0; t < 8; ++t) { const int r = 4 * rh + (t >> 1), u = t & 1;
                    const int kcol = wsc + 8 * (l15 >> 2) + 4 * u + (l15 & 3);
                    const bf16* kp = ZA + ((size_t)b * SEQ + (rs + r) * 64 + kcol) * 3072 + 1024 + h * 128 + 8 * q4;
#pragma unroll
                    for (int ks = 0; ks < 4; ++ks) kf[t][ks] = *(const bf16x8*)(kp + 32 * ks); }
                __builtin_amdgcn_sched_barrier(0);
#pragma unroll
                for (int t = 0; t < 8; ++t) { f32x4 acc = (f32x4){0.f, 0.f, 0.f, 0.f};
#pragma unroll
                    for (int ks = 0; ks < 4; ++ks) acc = __builtin_amdgcn_mfma_f32_16x16x32_bf16(kf[t][ks], qf[ks], acc, 0, 0, 0);
                    S[4 * rh + (t >> 1)][t & 1] = acc; }
            }
            float mx = -1e30f;
#pragma unroll
            for (int r = 0; r < 8; ++r)
#pragma unroll
                for (int u = 0; u < 2; ++u)
#pragma unroll
                    for (int j = 0; j < 4; ++j) {
                        const int kc = wsc + 8 * q4 + 4 * u + j;
                        const bool valid = (kc >= cs) && (kc < cs + 16);
                        const int bi = valid ? ((rs + r - i + 7) * 31 + (kc - jq + 15)) : 0;
                        const float sv = valid ? (S[r][u][j] + rpbl[bi]) : -1e30f;
                        S[r][u][j] = sv; mx = fmaxf(mx, sv);
                    }
            mx = fmaxf(mx, __shfl_xor(mx, 16)); mx = fmaxf(mx, __shfl_xor(mx, 32));
            float sum = 0.f;
#pragma unroll
            for (int r = 0; r < 8; ++r)
#pragma unroll
                for (int u = 0; u < 2; ++u)
#pragma unroll
                    for (int j = 0; j < 4; ++j) { const float p = __expf(S[r][u][j] - mx); S[r][u][j] = p; sum += p; }
            sum += __shfl_xor(sum, 16); sum += __shfl_xor(sum, 32);
            const float inv = 1.0f / sum;
            bf16x8 pf[8];
#pragma unroll
            for (int r = 0; r < 8; ++r) { v4u w; w.x = pk2(S[r][0][0], S[r][0][1]); w.y = pk2(S[r][0][2], S[r][0][3]); w.z = pk2(S[r][1][0], S[r][1][1]); w.w = pk2(S[r][1][2], S[r][1][3]);
                pf[r] = __builtin_bit_cast(bf16x8, w); }
#pragma unroll
            for (int dh = 0; dh < 2; ++dh) {
                bf16x8 vf[4][8];
#pragma unroll
                for (int d4 = 0; d4 < 4; ++d4) { const int dt = 4 * dh + d4;
                    const bf16* vp = VT + ((size_t)(b * 8 + h) * 128 + 16 * dt + l15) * SEQ + rs * 64 + wsc + 8 * q4;
#pragma unroll
                    for (int r = 0; r < 8; ++r) vf[d4][r] = *(const bf16x8*)(vp + r * 64); }
                __builtin_amdgcn_sched_barrier(0);
#pragma unroll
                for (int d4 = 0; d4 < 4; ++d4) { const int dt = 4 * dh + d4;
                    f32x4 o = (f32x4){0.f, 0.f, 0.f, 0.f};
#pragma unroll
                    for (int r = 0; r < 8; ++r) o = __builtin_amdgcn_mfma_f32_16x16x32_bf16(vf[d4][r], pf[r], o, 0, 0, 0);
                    const float i16 = inv * 16.f; int w = 0; w = __builtin_amdgcn_cvt_pk_fp8_f32(c448(o[0] * i16), c448(o[1] * i16), w, false); w = __builtin_amdgcn_cvt_pk_fp8_f32(c448(o[2] * i16), c448(o[3] * i16), w, true);
                    *(int*)((unsigned char*)OA + qtok * 1024 + h * 128 + 16 * dt + 4 * q4) = w; }
            }
        }
    }
}

typedef short bf16x4 __attribute__((ext_vector_type(4)));
typedef __bf16 bf16x2_t __attribute__((ext_vector_type(2)));
DI unsigned cvtpk(float lo, float hi) { f32x2 v = {lo, hi}; bf16x2_t b = __builtin_convertvector(v, bf16x2_t); return __builtin_bit_cast(unsigned, b); }
DI f32x4 mfma32(bf16x8 a, bf16x8 b, f32x4 c) { return __builtin_amdgcn_mfma_f32_16x16x32_bf16(a, b, c, 0, 0, 0); }
DI f32x4 mfma16(bf16x4 a, bf16x4 b, f32x4 c) { return __builtin_amdgcn_mfma_f32_16x16x16bf16_1k(a, b, c, 0, 0, 0); }
DI bf16x4 pack4(f32x4 v) { v2u w; w.x = cvtpk(v[0], v[1]); w.y = cvtpk(v[2], v[3]); return __builtin_bit_cast(bf16x4, w); }
DI bf16x8 pack8(f32x4 a, f32x4 b) { v4u w; w.x = cvtpk(a[0], a[1]); w.y = cvtpk(a[2], a[3]); w.z = cvtpk(b[0], b[1]); w.w = cvtpk(b[2], b[3]); return __builtin_bit_cast(bf16x8, w); }
#define SC_BARRIER() do { asm volatile("s_waitcnt lgkmcnt(0)" ::: "memory"); __builtin_amdgcn_s_barrier(); asm volatile("" ::: "memory"); } while (0)
constexpr int SC_SLOT = 16384, SC_SCR = 131072, SC_SCRB = 6528, SC_ROW = 136;
DI void phase_scan(const Args& a, const Ctx& c) {
    unsigned char* ws = a.ws;
    const bf16* R16 = (const bf16*)(ws + WS_R); const bf16* K16 = (const bf16*)(ws + WS_K); const bf16* V16 = (const bf16*)(ws + WS_V); const bf16* KK16 = (const bf16*)(ws + WS_KK);
    const int lane = c.lane, l15 = lane & 15, kq = lane >> 4;
    const f32x4 Z4 = (f32x4){0.f, 0.f, 0.f, 0.f};
    for (int job = c.bid; job < 256; job += c.G) {
        const int p = job >> 2, sg = job & 3, cb = 128 * sg, dir = p >> 5, b = (p >> 4) & 1, h = p & 15;
        bf16* PHI = (bf16*)(ws + (dir ? WS_PHIB : WS_PHIF));
        LAS float* rpbl = (LAS float*)(c.lds + 157824);
        for (int t_ = c.tid; t_ < 465; t_ += 512) rpbl[t_] = a.in[10][(((job * 32) >> 9) & 7) * 465 + t_];
        const bf16* IC = (const bf16*)(ws + (dir ? WS_ICB : WS_ICF)); const bf16* LW = (const bf16*)(ws + (dir ? WS_LWB : WS_LWF));
        bf16* O = (bf16*)(ws + (dir ? WS_OBW : WS_OF));
        __syncthreads();
        if (c.wave >= 4) {
            const int pw = c.wave - 4;
            LAS unsigned char* scr = c.lds + SC_SCR + pw * SC_SCRB;
            float ka[2][8];
#pragma unroll
            for (int ks = 0; ks < 2; ++ks)
#pragma unroll
                for (int e = 0; e < 8; ++e) ka[ks][e] = a.in[18][h * 64 + 32 * ks + 16 * (e >> 2) + 4 * kq + (e & 3)];
#pragma unroll
            for (int ks = 0; ks < 2; ++ks)
#pragma unroll
                for (int e = 0; e < 8; ++e) asm volatile("" : "+v"(ka[ks][e]));
            v2u raw[6][4], rawN[6][4];
#define SC_LOAD(dst, cc) do { const int ng_ = 16 * (cb + (cc)) + l15, t_ = dir ? (SEQ - 1 - ng_) : ng_; const size_t o_ = (size_t)(b * SEQ + t_) * 1024 + h * 64 + 4 * kq; \
                _Pragma("unroll") for (int g_ = 0; g_ < 4; ++g_) { dst[0][g_] = *(const v2u*)(R16 + o_ + 16 * g_); dst[1][g_] = *(const v2u*)(K16 + o_ + 16 * g_); dst[2][g_] = *(const v2u*)(V16 + o_ + 16 * g_); \
                    dst[3][g_] = *(const v2u*)(KK16 + o_ + 16 * g_); dst[4][g_] = *(const v2u*)(IC + o_ + 16 * g_); dst[5][g_] = *(const v2u*)(LW + o_ + 16 * g_); } } while (0)
#define SC_FLUSH(sl, ch) do { const int n_ = lane >> 2, pt_ = lane & 3, ng_ = 16 * (cb + (ch)) + n_, t_ = dir ? (SEQ - 1 - ng_) : ng_; \
                const LAS v4u* s_ = (const LAS v4u*)((sl) + 9984 + pt_ * 1536 + 512 + n_ * 32); const v4u x0_ = s_[0], x1_ = s_[1], y0_ = s_[32], y1_ = s_[33]; \
                const size_t go_ = (size_t)(b * SEQ + t_) * 1024 + h * 64 + 16 * pt_; \
                v4u* d_ = (v4u*)(O + go_); d_[0] = x0_; d_[1] = x1_; \
                if (sg > 0) { v4u* e_ = (v4u*)(PHI + (size_t)(b * 6144 + ng_ - 2048) * 1024 + h * 64 + 16 * pt_); e_[0] = y0_; e_[1] = y1_; } } while (0)
            SC_LOAD(raw, pw); SC_LOAD(rawN, pw + 4);
#pragma unroll 1
            for (int it = -1; it < 34; ++it) {
                const int cc = 4 * (it + 1) + pw;
                if (cc >= 128 && cc < 136) { SC_FLUSH(c.lds + (((it + 1) & 1) * 4 + pw) * SC_SLOT, cc - 8); }
                if (cc < 128) {
                    LAS unsigned char* slot = c.lds + (((it + 1) & 1) * 4 + pw) * SC_SLOT;
                    if (cc >= 8) SC_FLUSH(slot, cc - 8);
                    f32x4 mab_b = Z4, mab_a = Z4, mak_a = Z4, mrb_a = Z4, mrk_a = Z4;
#pragma unroll
                    for (int ks = 0; ks < 2; ++ks) {
                        float r[8], k[8], v[8], kk[8], ic[8], lw[8];
#pragma unroll
                        for (int hf = 0; hf < 2; ++hf) { const int g = 2 * ks + hf;
                            r[4 * hf] = bflo(raw[0][g].x); r[4 * hf + 1] = bfhi(raw[0][g].x); r[4 * hf + 2] = bflo(raw[0][g].y); r[4 * hf + 3] = bfhi(raw[0][g].y);
                            k[4 * hf] = bflo(raw[1][g].x); k[4 * hf + 1] = bfhi(raw[1][g].x); k[4 * hf + 2] = bflo(raw[1][g].y); k[4 * hf + 3] = bfhi(raw[1][g].y);
                            v[4 * hf] = bflo(raw[2][g].x); v[4 * hf + 1] = bfhi(raw[2][g].x); v[4 * hf + 2] = bflo(raw[2][g].y); v[4 * hf + 3] = bfhi(raw[2][g].y);
                            kk[4 * hf] = bflo(raw[3][g].x); kk[4 * hf + 1] = bfhi(raw[3][g].x); kk[4 * hf + 2] = bflo(raw[3][g].y); kk[4 * hf + 3] = bfhi(raw[3][g].y);
                            ic[4 * hf] = bflo(raw[4][g].x); ic[4 * hf + 1] = bfhi(raw[4][g].x); ic[4 * hf + 2] = bflo(raw[4][g].y); ic[4 * hf + 3] = bfhi(raw[4][g].y);
                            lw[4 * hf] = bflo(raw[5][g].x); lw[4 * hf + 1] = bfhi(raw[5][g].x); lw[4 * hf + 2] = bflo(raw[5][g].y); lw[4 * hf + 3] = bfhi(raw[5][g].y); }
                        float cum[8], tot[8];
#pragma unroll
                        for (int e = 0; e < 8; ++e) cum[e] = lw[e];
#pragma unroll
                        for (int e = 0; e < 8; ++e) { tot[e] = row16_sum(lw[e]);
                            cum[e] += dpp_mov<0x111>(cum[e]); cum[e] += dpp_mov<0x112>(cum[e]); cum[e] += dpp_mov<0x114>(cum[e]); cum[e] += dpp_mov<0x118>(cum[e]); }
                        float at[8], bh[8], kh[8], rt[8], bbv[8], kbv[8], gam[8];
#pragma unroll
                        for (int e = 0; e < 8; ++e) gam[e] = __expf(tot[e]);
#pragma unroll
                        for (int e = 0; e < 8; ++e) {
                            const float bb = kk[e] * ic[e], kd = k[e] * (1.0f + (ic[e] - 1.0f) * ka[ks][e]);
                            const float ep = __expf(cum[e]), en = __builtin_amdgcn_rcpf(ep), ex = ep * __expf(-lw[e]), et = gam[e] * en;
                            at[e] = -kk[e] * ex; bh[e] = bb * en; kh[e] = kd * en; rt[e] = r[e] * ep; bbv[e] = bb * et; kbv[e] = kd * et;
                        }
                        v4u w;
                        w.x = cvtpk(at[0], at[1]); w.y = cvtpk(at[2], at[3]); w.z = cvtpk(at[4], at[5]); w.w = cvtpk(at[6], at[7]); const bf16x8 at_f = __builtin_bit_cast(bf16x8, w);
                        w.x = cvtpk(bh[0], bh[1]); w.y = cvtpk(bh[2], bh[3]); w.z = cvtpk(bh[4], bh[5]); w.w = cvtpk(bh[6], bh[7]); const bf16x8 bh_f = __builtin_bit_cast(bf16x8, w);
                        w.x = cvtpk(kh[0], kh[1]); w.y = cvtpk(kh[2], kh[3]); w.z = cvtpk(kh[4], kh[5]); w.w = cvtpk(kh[6], kh[7]); const bf16x8 kh_f = __builtin_bit_cast(bf16x8, w);
                        w.x = cvtpk(rt[0], rt[1]); w.y = cvtpk(rt[2], rt[3]); w.z = cvtpk(rt[4], rt[5]); w.w = cvtpk(rt[6], rt[7]); const bf16x8 rt_f = __builtin_bit_cast(bf16x8, w);
                        *(LAS bf16x8*)(slot + ks * 1024 + lane * 16) = at_f;
                        *(LAS bf16x8*)(slot + 2048 + ks * 1024 + lane * 16) = rt_f;
                        mab_b = mfma32(at_f, bh_f, mab_b); mab_a = mfma32(bh_f, at_f, mab_a); mak_a = mfma32(kh_f, at_f, mak_a); mrb_a = mfma32(bh_f, rt_f, mrb_a); mrk_a = mfma32(kh_f, rt_f, mrk_a);
#pragma unroll
                        for (int hf = 0; hf < 2; ++hf) { const int chb = (32 * ks + 16 * hf + 4 * kq) * 2;
                            v2u q; q.x = cvtpk(bbv[4 * hf], bbv[4 * hf + 1]); q.y = cvtpk(bbv[4 * hf + 2], bbv[4 * hf + 3]); *(LAS v2u*)(scr + l15 * SC_ROW + chb) = q;
                            q.x = cvtpk(kbv[4 * hf], kbv[4 * hf + 1]); q.y = cvtpk(kbv[4 * hf + 2], kbv[4 * hf + 3]); *(LAS v2u*)(scr + 2176 + l15 * SC_ROW + chb) = q;
                            *(LAS v2u*)(scr + 4352 + l15 * SC_ROW + chb) = raw[2][2 * ks + hf]; }
                        if (l15 == 0) {
#pragma unroll
                            for (int e = 0; e < 8; ++e) *(LAS float*)(slot + 9728 + 4 * (32 * ks + 16 * (e >> 2) + 4 * kq + (e & 3))) = gam[e]; }
                    }
                    f32x4 idm;
#pragma unroll
                    for (int rg = 0; rg < 4; ++rg) { const int m = 4 * kq + rg;
                        if (!(m < l15)) { mab_a[rg] = 0.f; mak_a[rg] = 0.f; }
                        if (!(m <= l15)) { mrb_a[rg] = 0.f; mrk_a[rg] = 0.f; }
                        if (!(l15 < m)) mab_b[rg] = 0.f;
                        idm[rg] = (m == l15) ? 1.0f : 0.0f; }
                    const bf16x4 Ma = pack4(mab_a), Mb = pack4(mab_b);
                    const f32x4 m2b = mfma16(Ma, Mb, Z4), m2a = mfma16(Mb, Ma, Z4);
                    const bf16x4 M2a = pack4(m2a), M2b = pack4(m2b);
                    const f32x4 m4b = mfma16(M2a, M2b, Z4), m4a = mfma16(M2b, M2a, Z4);
                    const bf16x4 M4a = pack4(m4a), M4b = pack4(m4b);
                    const f32x4 m8b = mfma16(M4a, M4b, Z4);
                    const f32x4 q1a = mfma16(pack4(m2b + idm), pack4(mab_a + idm), Z4);
                    const f32x4 q2a = mfma16(pack4(m4b + idm), pack4(q1a), Z4);
                    const f32x4 ta = mfma16(pack4(m8b + idm), pack4(q2a), Z4);
                    *(LAS bf16x4*)(slot + 8192 + lane * 8) = pack4(ta);
                    *(LAS bf16x4*)(slot + 8704 + lane * 8) = pack4(mrb_a);
                    *(LAS bf16x4*)(slot + 9216 + lane * 8) = pack4(mrk_a);
                    const bf16x4 Mak = pack4(mak_a);
                    LDS_WAIT(); asm volatile("" ::: "memory");
#pragma unroll
                    for (int jt = 0; jt < 4; ++jt) {
                        unsigned e0[4], e1[4], e2[4];
#pragma unroll
                        for (int e = 0; e < 4; ++e) { const int o = (4 * kq + e) * SC_ROW + (16 * jt + l15) * 2;
                            e0[e] = *(const LAS unsigned short*)(scr + o); e1[e] = *(const LAS unsigned short*)(scr + 2176 + o); e2[e] = *(const LAS unsigned short*)(scr + 4352 + o); }
                        v4u bk; bk.x = e0[0] | (e0[1] << 16); bk.y = e0[2] | (e0[3] << 16); bk.z = e1[0] | (e1[1] << 16); bk.w = e1[2] | (e1[3] << 16);
                        *(LAS v4u*)(slot + 4096 + jt * 1024 + lane * 16) = bk;
                        v2u vf; vf.x = e2[0] | (e2[1] << 16); vf.y = e2[2] | (e2[3] << 16);
                        *(LAS v2u*)(slot + 9984 + jt * 1536 + lane * 8) = vf;
                        const f32x4 w2 = mfma16(Mak, __builtin_bit_cast(bf16x4, vf), Z4);
                        *(LAS f32x4*)(slot + 9984 + jt * 1536 + 512 + lane * 16) = w2;
                    }
                    LDS_WAIT(); asm volatile("" ::: "memory");
                }
#pragma unroll
                for (int i = 0; i < 6; ++i)
#pragma unroll
                    for (int g = 0; g < 4; ++g) raw[i][g] = rawN[i][g];
                if (cc + 8 < 128) SC_LOAD(rawN, cc + 8);
                SC_BARRIER();
            }
#undef SC_LOAD
#undef SC_FLUSH
        } else {
            if (c.wave >= 2) {
                const bf16* ZA = (const bf16*)(ws + WS_ZA); const bf16* VT = (const bf16*)(ws + WS_VT); bf16* OA = (bf16*)(ws + WS_OA);
                bf16x8 pf[8]; float inv = 0.f; f32x4 Sa[8][2];
#pragma unroll
                for (int r = 0; r < 8; ++r) { pf[r] = (bf16x8){0, 0, 0, 0, 0, 0, 0, 0}; Sa[r][0] = Z4; Sa[r][1] = Z4; }
#pragma unroll 1
                for (int it = -1; it < 34; ++it) {
                    const int pi = it + 1;
                    if (pi < 32) { const int id = job * 32 + 2 * (pi >> 2) + (c.wave - 2);
                        NaTask t; t.cq = id & 3; t.i = (id >> 2) & 127; t.h = (id >> 9) & 7; t.b = id >> 12;
                        const int part = pi & 3;
                        if (part == 0) na_part_a(ZA, rpbl, lane, t, 0, Sa, pf, inv); else if (part == 1) na_part_a(ZA, rpbl, lane, t, 1, Sa, pf, inv);
                        else if (part == 2) na_part_b(VT, OA, lane, t, 0, pf, inv); else na_part_b(VT, OA, lane, t, 1, pf, inv); }
                    SC_BARRIER();
                }
            } else {
            f32x4 S[2][4], P[2][4];
#pragma unroll
            for (int vv = 0; vv < 2; ++vv)
#pragma unroll
                for (int jt = 0; jt < 4; ++jt) { S[vv][jt] = Z4;
#pragma unroll
                    for (int rg = 0; rg < 4; ++rg) P[vv][jt][rg] = (16 * jt + 4 * kq + rg == 16 * (2 * c.wave + vv) + l15) ? 1.0f : 0.0f; }
#pragma unroll 1
            for (int it = -1; it < 34; ++it) {
                if (it >= 0 && it < 32) {
#pragma unroll 1
                    for (int q = 0; q < 4; ++q) {
                        LAS unsigned char* slot = c.lds + ((it & 1) * 4 + q) * SC_SLOT;
                        const bf16x8 at0 = *(const LAS bf16x8*)(slot + lane * 16), at1 = *(const LAS bf16x8*)(slot + 1024 + lane * 16);
                        const bf16x8 rt0 = *(const LAS bf16x8*)(slot + 2048 + lane * 16), rt1 = *(const LAS bf16x8*)(slot + 3072 + lane * 16);
                        const bf16x4 Ta = *(const LAS bf16x4*)(slot + 8192 + lane * 8), Mrb = *(const LAS bf16x4*)(slot + 8704 + lane * 8), Mrk = *(const LAS bf16x4*)(slot + 9216 + lane * 8);
                        bf16x8 bkf[4]; f32x4 gam[4];
#pragma unroll
                        for (int jt = 0; jt < 4; ++jt) { gam[jt] = *(const LAS f32x4*)(slot + 9728 + (16 * jt + 4 * kq) * 4); bkf[jt] = *(const LAS bf16x8*)(slot + 4096 + jt * 1024 + lane * 16); }
#pragma unroll
                        for (int vv = 0; vv < 2; ++vv) {
                            const int vt = 2 * c.wave + vv;
                            const bf16x4 Vf = *(const LAS bf16x4*)(slot + 9984 + vt * 1536 + lane * 8);
                            const f32x4 W2 = *(const LAS f32x4*)(slot + 9984 + vt * 1536 + 512 + lane * 16);
                            const bf16x8 sp0 = pack8(S[vv][0], S[vv][1]), sp1 = pack8(S[vv][2], S[vv][3]);
                            f32x4 X = mfma32(at0, sp0, W2); X = mfma32(at1, sp1, X);
                            f32x4 Oc = mfma32(rt0, sp0, Z4); Oc = mfma32(rt1, sp1, Oc);
                            const f32x4 U = mfma16(Ta, pack4(X), Z4);
                            const bf16x4 Up = pack4(U);
                            Oc = mfma16(Mrb, Up, Oc); Oc = mfma16(Mrk, Vf, Oc);
                            const v2u upw = __builtin_bit_cast(v2u, Up), vfw = __builtin_bit_cast(v2u, Vf);
                            const bf16x8 UV = __builtin_bit_cast(bf16x8, ((v4u){upw.x, upw.y, vfw.x, vfw.y}));
                            const bf16x8 pp0 = pack8(P[vv][0], P[vv][1]), pp1 = pack8(P[vv][2], P[vv][3]);
                            f32x4 Xp = mfma32(at0, pp0, Z4); Xp = mfma32(at1, pp1, Xp);
                            f32x4 Op = mfma32(rt0, pp0, Z4); Op = mfma32(rt1, pp1, Op);
                            const bf16x4 Upp = pack4(mfma16(Ta, pack4(Xp), Z4));
                            Op = mfma16(Mrb, Upp, Op);
                            const v2u uppw = __builtin_bit_cast(v2u, Upp);
                            const bf16x8 UVp = __builtin_bit_cast(bf16x8, ((v4u){uppw.x, uppw.y, 0u, 0u}));
#pragma unroll
                            for (int jt = 0; jt < 4; ++jt) { S[vv][jt] = mfma32(bkf[jt], UV, S[vv][jt] * gam[jt]); P[vv][jt] = mfma32(bkf[jt], UVp, P[vv][jt] * gam[jt]); }
                            LAS bf16* ost = (LAS bf16*)(slot + 9984 + vt * 1536 + 512);
#pragma unroll
                            for (int rg = 0; rg < 4; ++rg) { ost[(4 * kq + rg) * 16 + l15] = (bf16)(cvtpk(Oc[rg], 0.f) & 0xffffu); ost[256 + (4 * kq + rg) * 16 + l15] = (bf16)(cvtpk(Op[rg], 0.f) & 0xffffu); }
                        }
                    }
                }
                SC_BARRIER();
            }
            float* QS = (float*)(ws + WS_QS) + (size_t)job * 4096; float* PS = (float*)(ws + WS_PS) + (size_t)job * 4096;
#pragma unroll
            for (int vv = 0; vv < 2; ++vv)
#pragma unroll
                for (int jt = 0; jt < 4; ++jt) { const int vt = 2 * c.wave + vv;
                    *(f32x4*)(QS + (16 * vt + l15) * 64 + 16 * jt + 4 * kq) = S[vv][jt]; *(f32x4*)(PS + (16 * vt + l15) * 64 + 16 * jt + 4 * kq) = P[vv][jt]; }
            }
        }
    }
}
DI void phase_scan_chain(const Args& a, const Ctx& c) {
    unsigned char* ws = a.ws;
    LAS float* Sc = (LAS float*)c.lds;
    LAS float* Pm = (LAS float*)(c.lds + 16640);
    const int v = c.tid >> 3, jg = c.tid & 7;
    for (int p = c.bid; p < 64; p += c.G) {
        const float* QS = (const float*)(ws + WS_QS) + (size_t)p * 4 * 4096; const float* PS = (const float*)(ws + WS_PS) + (size_t)p * 4 * 4096;
        bf16* SST = (bf16*)(ws + WS_SST) + (size_t)p * 4 * 4096;
        float acc[8];
#pragma unroll
        for (int e = 0; e < 8; ++e) acc[e] = QS[v * 64 + 8 * jg + e];
#pragma unroll 1
        for (int seg = 1; seg < 4; ++seg) {
            __syncthreads();
#pragma unroll
            for (int e = 0; e < 8; ++e) Sc[v * 65 + 8 * jg + e] = acc[e];
            { v4u o; o.x = pk2(acc[0], acc[1]); o.y = pk2(acc[2], acc[3]); o.z = pk2(acc[4], acc[5]); o.w = pk2(acc[6], acc[7]); *(v4u*)(SST + seg * 4096 + v * 64 + 8 * jg) = o; }
            if (seg == 3) break;
            for (int i = 0; i < 8; ++i) Pm[c.tid + 512 * i] = PS[seg * 4096 + c.tid + 512 * i];
            __syncthreads();
#pragma unroll
            for (int e = 0; e < 8; ++e) acc[e] = QS[seg * 4096 + v * 64 + 8 * jg + e];
            for (int i = 0; i < 64; ++i) { const float sv = Sc[v * 65 + i];
#pragma unroll
                for (int e = 0; e < 8; ++e) acc[e] += sv * Pm[i * 64 + 8 * jg + e]; }
        }
        __syncthreads();
    }
}
DI void phase_scan_fix(const Args& a, const Ctx& c) {
    unsigned char* ws = a.ws;
    const int lane = c.lane, l15 = lane & 15, kq = lane >> 4;
    const f32x4 Z4 = (f32x4){0.f, 0.f, 0.f, 0.f};
    for (int item = c.gw; item < 64 * 3 * 128; item += c.NGW) {
        const int tile = item & 127, ps = item >> 7, seg = 1 + ps % 3, p = ps / 3, dir = p >> 5, b = (p >> 4) & 1, h = p & 15;
        const bf16* PHI = (const bf16*)(ws + (dir ? WS_PHIB : WS_PHIF)); bf16* O = (bf16*)(ws + (dir ? WS_OBW : WS_OF));
        const bf16* SST = (const bf16*)(ws + WS_SST) + (size_t)(p * 4 + seg) * 4096;
        const int ng0 = 16 * (128 * seg + tile);
        const size_t pa = (size_t)(b * 6144 + ng0 + l15 - 2048) * 1024 + h * 64;
        const bf16x8 a0 = *(const bf16x8*)(PHI + pa + 8 * kq), a1 = *(const bf16x8*)(PHI + pa + 32 + 8 * kq);
#pragma unroll
        for (int vt = 0; vt < 4; ++vt) {
            const bf16x8 b0 = *(const bf16x8*)(SST + (16 * vt + l15) * 64 + 8 * kq), b1 = *(const bf16x8*)(SST + (16 * vt + l15) * 64 + 32 + 8 * kq);
            f32x4 cc = mfma32(a0, b0, Z4); cc = mfma32(a1, b1, cc);
#pragma unroll
            for (int rg = 0; rg < 4; ++rg) { const int ng = ng0 + 4 * kq + rg, t = dir ? (SEQ - 1 - ng) : ng;
                bf16* op = O + (size_t)(b * SEQ + t) * 1024 + h * 64 + 16 * vt + l15;
                *op = (bf16)(cvtpk(bflo((unsigned)*op) + cc[rg], 0.f) & 0xffffu); }
        }
    }
}

DI void phase_rwkv_post(const Args& a, const Ctx& c) {
    unsigned char* ws = a.ws;
    const bf16* OF = (const bf16*)(ws + WS_OF); const bf16* OB = (const bf16*)(ws + WS_OBW);
    const bf16* R16 = (const bf16*)(ws + WS_R); const bf16* K16 = (const bf16*)(ws + WS_K); const bf16* V16 = (const bf16*)(ws + WS_V); const bf16* G16 = (const bf16*)(ws + WS_G);
    bf16* OUT = (bf16*)(ws + WS_OB16);
    const int c0 = c.lane * 16;
    float rk[16], lnw[16], lnb[16];
#pragma unroll
    for (int e = 0; e < 16; ++e) { rk[e] = a.in[19][c0 + e]; lnw[e] = a.in[20][c0 + e]; lnb[e] = a.in[21][c0 + e]; }
    for (int row = c.gw; row < MROWS; row += c.NGW) {
        const size_t off = (size_t)row * 1024 + c0;
        float o[16], r[16], k[16], v[16], g[16];
#pragma unroll
        for (int hh = 0; hh < 2; ++hh) {
            const v4u uf = *(const v4u*)(OF + off + 8 * hh), ub = *(const v4u*)(OB + off + 8 * hh), ur = *(const v4u*)(R16 + off + 8 * hh), uk = *(const v4u*)(K16 + off + 8 * hh),
                      uv = *(const v4u*)(V16 + off + 8 * hh), ug = *(const v4u*)(G16 + off + 8 * hh);
            const unsigned f4[4] = {uf.x, uf.y, uf.z, uf.w}, b4[4] = {ub.x, ub.y, ub.z, ub.w}, r4[4] = {ur.x, ur.y, ur.z, ur.w}, k4[4] = {uk.x, uk.y, uk.z, uk.w}, v4[4] = {uv.x, uv.y, uv.z, uv.w}, g4[4] = {ug.x, ug.y, ug.z, ug.w};
#pragma unroll
            for (int e = 0; e < 4; ++e) { const int i0 = 8 * hh + 2 * e;
                o[i0] = bflo(f4[e]) + bflo(b4[e]); o[i0 + 1] = bfhi(f4[e]) + bfhi(b4[e]);
                r[i0] = bflo(r4[e]); r[i0 + 1] = bfhi(r4[e]); k[i0] = bflo(k4[e]); k[i0 + 1] = bfhi(k4[e]);
                v[i0] = bflo(v4[e]); v[i0 + 1] = bfhi(v4[e]); g[i0] = bflo(g4[e]); g[i0 + 1] = bfhi(g4[e]); }
        }
        float s = 0.f, bs = 0.f;
#pragma unroll
        for (int e = 0; e < 16; ++e) { s += o[e]; bs += r[e] * k[e] * rk[e]; }
        s += __shfl_xor(s, 1); s += __shfl_xor(s, 2); bs += __shfl_xor(bs, 1); bs += __shfl_xor(bs, 2);
        const float mean = s * (1.0f / 64.0f);
        float q = 0.f;
#pragma unroll
        for (int e = 0; e < 16; ++e) { o[e] -= mean; q += o[e] * o[e]; }
        q += __shfl_xor(q, 1); q += __shfl_xor(q, 2);
        const float rstd = rsqrtf(q * (1.0f / 64.0f) + 64e-5f);
        float y[16];
#pragma unroll
        for (int e = 0; e < 16; ++e) y[e] = (o[e] * rstd * lnw[e] + lnb[e] + bs * v[e]) * g[e];
        int t[4];
#pragma unroll
        for (int q = 0; q < 4; ++q) { t[q] = 0; t[q] = __builtin_amdgcn_cvt_pk_fp8_f32(c448(y[4 * q] * 16.f), c448(y[4 * q + 1] * 16.f), t[q], false); t[q] = __builtin_amdgcn_cvt_pk_fp8_f32(c448(y[4 * q + 2] * 16.f), c448(y[4 * q + 3] * 16.f), t[q], true); }
        v4u w0; w0.x = (unsigned)t[0]; w0.y = (unsigned)t[1]; w0.z = (unsigned)t[2]; w0.w = (unsigned)t[3];
        *(v4u*)((unsigned char*)OUT + off) = w0;
    }
}

DI void tables_load(const Args& a, int lane, int rp, f32x4 (&v)[2][8]) {
    if (rp >= 16384) return;
#pragma unroll
    for (int z = 0; z < 2; ++z) { const int rowi = 2 * rp + z, tb = rowi >> 14, row = rowi & 16383;
        const float* src = a.in[28 + tb] + (size_t)row * 2048 + lane * 4;
#pragma unroll
        for (int i = 0; i < 8; ++i) v[z][i] = *(const f32x4*)(src + 256 * i); }
}
DI void tables_finish(const Args& a, int lane, int rp, f32x4 (&v)[2][8]) {
    if (rp >= 16384) return;
    float* SC = (float*)(a.ws + WS_PSC);
    float mx[2];
#pragma unroll
    for (int z = 0; z < 2; ++z) { float m = 0.f;
#pragma unroll
        for (int i = 0; i < 8; ++i) m = fmaxf(m, fmaxf(fmaxf(fabsf(v[z][i].x), fabsf(v[z][i].y)), fmaxf(fabsf(v[z][i].z), fabsf(v[z][i].w))));
        mx[z] = wave_max_fast(m); }
#pragma unroll
    for (int z = 0; z < 2; ++z) { const int rowi = 2 * rp + z, tb = rowi >> 14, row = rowi & 16383;
        const float scale = (mx[z] > 0.f) ? mx[z] * (1.0f / 224.0f) : 1.0f, inv = 1.0f / scale;
        unsigned char* dst = a.ws + (tb ? WS_PV : WS_PU) + ((size_t)(lane >> 5) * 16384 + row) * 128 + ((lane * 4) & 127);
#pragma unroll
        for (int i = 0; i < 8; ++i) { int t = 0; t = __builtin_amdgcn_cvt_pk_fp8_f32(v[z][i].x * inv, v[z][i].y * inv, t, false); t = __builtin_amdgcn_cvt_pk_fp8_f32(v[z][i].z * inv, v[z][i].w * inv, t, true);
            *(unsigned*)(dst + (size_t)(2 * i) * 16384 * 128) = (unsigned)t; }
        if (lane == 0) SC[rowi] = scale; }
}

DI void sort8_desc(float (&a)[8]) {
#define R_CE(i, j) { const float hi_ = fmaxf(a[i], a[j]), lo_ = fminf(a[i], a[j]); a[i] = hi_; a[j] = lo_; }
    R_CE(0, 1) R_CE(2, 3) R_CE(4, 5) R_CE(6, 7)
    R_CE(0, 2) R_CE(1, 3) R_CE(4, 6) R_CE(5, 7)
    R_CE(1, 2) R_CE(5, 6)
    R_CE(0, 4) R_CE(1, 5) R_CE(2, 6) R_CE(3, 7)
    R_CE(2, 4) R_CE(3, 5)
    R_CE(1, 2) R_CE(3, 4) R_CE(5, 6)
#undef R_CE
}
template <int NCH> DI void top16_rows(float (&a)[NCH][8], int i, float (&outv)[NCH], int (&outi)[NCH]) {
#pragma unroll
    for (int ch = 0; ch < NCH; ++ch) { outv[ch] = 0.f; outi[ch] = 0; sort8_desc(a[ch]); }
#pragma unroll 1
    for (int it = 0; it < 16; ++it) {
#pragma unroll
        for (int ch = 0; ch < NCH; ++ch) {
            const float wm = row16_max(a[ch][0]);
            const bool own = (a[ch][0] == wm);
#pragma unroll
            for (int k = 0; k < 7; ++k) a[ch][k] = own ? a[ch][k + 1] : a[ch][k];
            a[ch][7] = own ? -INFINITY : a[ch][7];
            if (i == it) { outv[ch] = __uint_as_float(__float_as_uint(wm) & ~127u); outi[ch] = (int)(__float_as_uint(wm) & 127u); }
        }
    }
}
DI void phase_route(const Args& a, const Ctx& c) {
    unsigned char* ws = a.ws;
    const float* SC = (const float*)(ws + WS_SC);
    int* EIDX = (int*)(ws + WS_EIDX); float* EGV = (float*)(ws + WS_EGV);
    const int lane = c.lane, r = lane >> 4, i = lane & 15, rowbase = lane & 48;
    int trip = 0;
    for (int tp = c.gw; tp < MROWS / 2; tp += c.NGW, ++trip) {
        f32x4 trow[2][8];
        const int rpA = c.gw + c.NGW * (2 * trip), rpB = rpA + c.NGW;
        tables_load(a, lane, rpA, trow);
        float sc[8][8];
#pragma unroll
        for (int ch = 0; ch < 8; ++ch) { const float* sp = SC + (size_t)(2 * tp + (ch >> 2)) * 2048 + (4 * ((ch >> 1) & 1) + r) * 256 + 128 * (ch & 1);
#pragma unroll
            for (int k = 0; k < 8; ++k) sc[ch][k] = __uint_as_float((__float_as_uint(sp[i + 16 * k]) & ~127u) | (unsigned)(i + 16 * k)); }
        float tv_[8]; int ti_[8];
        top16_rows<8>(sc, i, tv_, ti_);
        tables_finish(a, lane, rpA, trow);
        tables_load(a, lane, rpB, trow);
        int p[4] = {0, 0, 0, 0}; float cand[4], tv[4] = {0.f, 0.f, 0.f, 0.f}; int tf[4] = {0, 0, 0, 0};
#pragma unroll
        for (int ps = 0; ps < 4; ++ps) cand[ps] = __uint_as_float((__float_as_uint(tv_[2 * ps] + __shfl(tv_[2 * ps + 1], rowbase)) & ~255u) | (unsigned)(i << 4));
#pragma unroll 1
        for (int it = 0; it < 16; ++it) {
#pragma unroll
            for (int ps = 0; ps < 4; ++ps) {
                const float wm = row16_max(cand[ps]);
                if (i == it) { tv[ps] = __uint_as_float(__float_as_uint(wm) & ~255u); tf[ps] = (int)(__float_as_uint(wm) & 255u); }
                if (cand[ps] == wm) p[ps] += 1;
                const float nv = __shfl(tv_[2 * ps + 1], rowbase | (p[ps] & 15));
                cand[ps] = (p[ps] < 16) ? __uint_as_float((__float_as_uint(tv_[2 * ps] + nv) & ~255u) | (unsigned)((i << 4) | p[ps])) : -INFINITY;
            }
        }
#pragma unroll
        for (int ps = 0; ps < 4; ++ps) {
            const int token = 2 * tp + (ps >> 1), h = 4 * (ps & 1) + r;
            const int ia = __shfl(ti_[2 * ps], rowbase | (tf[ps] >> 4)), ib = __shfl(ti_[2 * ps + 1], rowbase | (tf[ps] & 15));
            const float t0 = __shfl(tv[ps], rowbase);
            const float ex = __expf(tv[ps] - t0);
            const float sm = row16_sum(ex);
            const int id = ia * 128 + ib;
            const size_t o = (size_t)token * 128 + h * 16 + i;
            EIDX[o] = id; EGV[o] = ex / sm;
        }
        tables_finish(a, lane, rpB, trow);
    }
}

DI float dot16_fp8(const v4u w, const float* x) {
    float s = 0.f;
    const unsigned ww[4] = {w.x, w.y, w.z, w.w};
#pragma unroll
    for (int q = 0; q < 4; ++q) { const f32x2 lo = __builtin_amdgcn_cvt_pk_f32_fp8((int)ww[q], false), hi = __builtin_amdgcn_cvt_pk_f32_fp8((int)ww[q], true);
        s += x[4 * q] * lo.x + x[4 * q + 1] * lo.y + x[4 * q + 2] * hi.x + x[4 * q + 3] * hi.y; }
    return s;
}
DI void axpy16_fp8(const v4u w, float g, float* acc) {
    const unsigned ww[4] = {w.x, w.y, w.z, w.w};
#pragma unroll
    for (int q = 0; q < 4; ++q) { const f32x2 lo = __builtin_amdgcn_cvt_pk_f32_fp8((int)ww[q], false), hi = __builtin_amdgcn_cvt_pk_f32_fp8((int)ww[q], true);
        acc[4 * q] += g * lo.x; acc[4 * q + 1] += g * lo.y; acc[4 * q + 2] += g * hi.x; acc[4 * q + 3] += g * hi.y; }
}
DI void peer_item(const Ctx& c, int it, int& s, int& tok0) { s = 2 * (it & 7) + (it >> 8); tok0 = ((it >> 3) & 31) * 512 + c.wave * 64; }
#define PEER_PIN4(v) asm volatile("" : "+v"(v.x), "+v"(v.y), "+v"(v.z), "+v"(v.w))
DI void phase_peer_u(const Args& a, const Ctx& c) {
    unsigned char* ws = a.ws;
    const bf16* U2 = (const bf16*)(ws + WS_U2); const int* EIDX = (const int*)(ws + WS_EIDX); float* HP = (float*)(ws + WS_HP);
    const int lane = c.lane, g = lane >> 3, part = lane & 7;
#pragma unroll 1
    for (int it = c.bid; it < 512; it += c.G) {
        int s, tok0; peer_item(c, it, s, tok0);
        const unsigned char* tab = ws + WS_PU + (size_t)s * 16384 * 128 + part * 16;
        v4u idn[2][4], xn[2][2];
#define PU_REQ(tk) do { _Pragma("unroll") for (int z_ = 0; z_ < 2; ++z_) { const size_t t_ = (size_t)((tk) + z_); \
            _Pragma("unroll") for (int q_ = 0; q_ < 4; ++q_) idn[z_][q_] = *(const v4u*)(EIDX + t_ * 128 + 16 * g + 4 * q_); \
            xn[z_][0] = *(const v4u*)(U2 + t_ * 2048 + 128 * s + 16 * part); xn[z_][1] = *(const v4u*)(U2 + t_ * 2048 + 128 * s + 16 * part + 8); } } while (0)
        PU_REQ(tok0);
#pragma unroll 1
        for (int tt = 0; tt < 64; tt += 2) {
            const int token = tok0 + tt;
            v4u w[2][16]; float x[2][16];
#pragma unroll
            for (int z = 0; z < 2; ++z) {
                const unsigned idv[16] = {idn[z][0].x, idn[z][0].y, idn[z][0].z, idn[z][0].w, idn[z][1].x, idn[z][1].y, idn[z][1].z, idn[z][1].w, idn[z][2].x, idn[z][2].y, idn[z][2].z, idn[z][2].w, idn[z][3].x, idn[z][3].y, idn[z][3].z, idn[z][3].w};
#pragma unroll
                for (int i = 0; i < 16; ++i) w[z][i] = *(const v4u*)(tab + (size_t)idv[i] * 128);
                const v4u u0 = xn[z][0], u1 = xn[z][1];
                x[z][0] = bflo(u0.x); x[z][1] = bfhi(u0.x); x[z][2] = bflo(u0.y); x[z][3] = bfhi(u0.y); x[z][4] = bflo(u0.z); x[z][5] = bfhi(u0.z); x[z][6] = bflo(u0.w); x[z][7] = bfhi(u0.w);
                x[z][8] = bflo(u1.x); x[z][9] = bfhi(u1.x); x[z][10] = bflo(u1.y); x[z][11] = bfhi(u1.y); x[z][12] = bflo(u1.z); x[z][13] = bfhi(u1.z); x[z][14] = bflo(u1.w); x[z][15] = bfhi(u1.w);
            }
            if (tt + 2 < 64) PU_REQ(token + 2);
#pragma unroll
            for (int z = 0; z < 2; ++z) {
                float hv0 = 0.f, hv1 = 0.f;
#pragma unroll
                for (int i = 0; i < 16; ++i) { const float d = group8_sum(dot16_fp8(w[z][i], x[z])); if (part == (i & 7)) { if (i < 8) hv0 = d; else hv1 = d; } }
                float* hp = HP + ((size_t)s * MROWS + token + z) * 128 + 16 * g + part;
                hp[0] = hv0; hp[8] = hv1;
            }
#pragma unroll
            for (int z = 0; z < 2; ++z) { PEER_PIN4(idn[z][0]); PEER_PIN4(idn[z][1]); PEER_PIN4(idn[z][2]); PEER_PIN4(idn[z][3]); PEER_PIN4(xn[z][0]); PEER_PIN4(xn[z][1]); }
        }
#undef PU_REQ
    }
}
DI void phase_peer_h(const Args& a, const Ctx& c) {
    unsigned char* ws = a.ws;
    const float* HP = (const float*)(ws + WS_HP); const int* EIDX = (const int*)(ws + WS_EIDX); const float* PSC = (const float*)(ws + WS_PSC); const float* EGV = (const float*)(ws + WS_EGV); float* GVP = (float*)(ws + WS_GVP);
    for (int i = c.bid * 512 + c.tid; i < MROWS * 128; i += c.G * 512) {
        const int id = EIDX[i];
        float h = 0.f;
#pragma unroll
        for (int s = 0; s < 16; ++s) h += HP[(size_t)s * MROWS * 128 + i];
        h *= PSC[id];
        GVP[i] = 0.5f * h * (1.0f + erff(h * 0.70710678118654752f)) * EGV[i] * PSC[16384 + id];
    }
}
DI void phase_peer_v(const Args& a, const Ctx& c) {
    unsigned char* ws = a.ws;
    const int* EIDX = (const int*)(ws + WS_EIDX); const float* GVP = (const float*)(ws + WS_GVP); const float* mod = (const float*)(ws + WS_MOD);
    const int lane = c.lane, g = lane >> 3, part = lane & 7;
#pragma unroll 1
    for (int it = c.bid; it < 512; it += c.G) {
        int s, tok0; peer_item(c, it, s, tok0);
        const unsigned char* tab = ws + WS_PV + (size_t)s * 16384 * 128 + part * 16;
        v4u idn[4]; f32x4 gn[4];
#define PV_REQ(tk) do { const size_t t_ = (size_t)(tk); \
            _Pragma("unroll") for (int q_ = 0; q_ < 4; ++q_) { idn[q_] = *(const v4u*)(EIDX + t_ * 128 + 16 * g + 4 * q_); gn[q_] = *(const f32x4*)(GVP + t_ * 128 + 16 * g + 4 * q_); } } while (0)
        PV_REQ(tok0);
#pragma unroll 1
        for (int tt = 0; tt < 64; ++tt) {
            const int token = tok0 + tt;
            v4u w[16]; float gv[16];
            const unsigned idv[16] = {idn[0].x, idn[0].y, idn[0].z, idn[0].w, idn[1].x, idn[1].y, idn[1].z, idn[1].w, idn[2].x, idn[2].y, idn[2].z, idn[2].w, idn[3].x, idn[3].y, idn[3].z, idn[3].w};
#pragma unroll
            for (int i = 0; i < 16; ++i) w[i] = *(const v4u*)(tab + (size_t)idv[i] * 128);
#pragma unroll
            for (int q = 0; q < 4; ++q) { gv[4 * q] = gn[q].x; gv[4 * q + 1] = gn[q].y; gv[4 * q + 2] = gn[q].z; gv[4 * q + 3] = gn[q].w; }
            if (tt + 1 < 64) PV_REQ(token + 1);
            float acc[16];
#pragma unroll
            for (int i = 0; i < 16; ++i) acc[i] = 0.f;
#pragma unroll
            for (int i = 0; i < 16; ++i) axpy16_fp8(w[i], gv[i], acc);
#pragma unroll
            for (int i = 0; i < 16; ++i) { float v = acc[i]; v += dpp_mov<0x128>(v); v += __shfl_xor(v, 16); v += __shfl_xor(v, 32); acc[i] = v; }
            if (g == 0) {
                const int b = token >> 13, col = 128 * s + 16 * part;
                const float* g2 = mod + (size_t)b * 12288 + 10240 + col; float* op = a.out + (size_t)token * 2048 + col;
#pragma unroll
                for (int q = 0; q < 4; ++q) { const f32x4 xa = *(const f32x4*)(op + 4 * q), ga = *(const f32x4*)(g2 + 4 * q);
                    f32x4 o; o.x = xa.x + ga.x * acc[4 * q]; o.y = xa.y + ga.y * acc[4 * q + 1]; o.z = xa.z + ga.z * acc[4 * q + 2]; o.w = xa.w + ga.w * acc[4 * q + 3];
                    *(f32x4*)(op + 4 * q) = o; }
            }
#pragma unroll
            for (int q = 0; q < 4; ++q) { PEER_PIN4(idn[q]); PEER_PIN4(gn[q]); }
        }
#undef PV_REQ
    }
}

__global__ void __launch_bounds__(NWAVES * 64, 2) hybrid_fwd(Args args) {
    extern __shared__ __attribute__((aligned(16))) unsigned char lds[];
    Ctx c;
#define FRESH_CTX() do { int t_ = threadIdx.x; asm volatile("" : "+v"(t_)); c.lds = (LAS unsigned char*)lds; c.tid = t_; c.lane = c.tid & 63; c.wave = __builtin_amdgcn_readfirstlane(c.tid >> 6); \
    c.G = gridDim.x; c.bid = blockIdx.x; c.gw = c.bid * NWAVES + c.wave; c.NGW = c.G * NWAVES; } while (0)
    FRESH_CTX();
    volatile LAS unsigned* MISC = (volatile LAS unsigned*)(c.lds + MISC_OFF);
    unsigned char* ws = args.ws;
    unsigned* ctl = (unsigned*)(ws + WS_CTL);
    if (c.tid < 32) MISC[c.tid] = 0u;
    __syncthreads();
    XcdBarrier bar; bar.bar = ctl + CW_BAR; bar.x = 0; bar.st = nullptr;
#if !MK_PER_PHASE
    bar = xcd_barrier_post(ctl + CW_BAR, MISC + 8);
#endif
    const int lo = args.ph_lo, hi = args.ph_hi;
#ifndef PHASE_MASK
#define PHASE_MASK 0x3ffff
#endif
#define IN(k) ((((PHASE_MASK) >> (k)) & 1) && lo <= (k) && (k) < hi)
#define SEAM(k) do { if (IN(k) && IN((k) + 1)) xcd_barrier(bar); } while (0)
    const float* mod = (const float*)(ws + WS_MOD);
    LAS unsigned char* ring = c.lds;

    if (IN(0)) { FRESH_CTX(); phase_prologue(args, c); } SEAM(0);
    if (IN(1)) { FRESH_CTX(); phase_norm_mod<true>(c, args.in[0], args.in[4], mod, 0, 2048, (bf16*)(ws + WS_U16)); } SEAM(1);
    if (IN(2)) {
        pg8::Gemm g{(const pg8::bf16_t*)(ws + WS_U16), (const pg8::bf16_t*)(ws + WS_WIN), MROWS, NZ, DM / 2, nullptr, nullptr, 0x75757575u, 0x7C7C7C7Cu}; pg8::StaticOrder S; S.init(MROWS, NZ, c.G, c.bid);
        pg8::EpiZ E{(pg8::bf16_t*)(ws + WS_ZA), (pg8::bf16_t*)(ws + WS_ZB), (pg8::bf16_t*)args.out, args.in[7]};
        pg8::gemm_phase<pg8::EpiZ, pg8::StaticOrder, true, true, false, true>(ring, g, S, E);
    } SEAM(2);
    if (IN(3)) { FRESH_CTX(); phase_qknorm_prep(args, c); phase_vtranspose(args, c); } SEAM(3);
    if (IN(4)) {
        pg8::Gemm g{(const pg8::bf16_t*)(ws + WS_T), (const pg8::bf16_t*)(ws + WS_LORA), MROWS, 5120, 256};
        pg8::GroupedOrder S; S.init(MROWS, 5120, c.G, c.bid); S.a_stride = (size_t)MROWS * 256 * 2;
        pg8::EpiLora E{{(pg8::bf16_t*)(ws + WS_LWF), (pg8::bf16_t*)(ws + WS_LWB), (pg8::bf16_t*)(ws + WS_ICF), (pg8::bf16_t*)(ws + WS_ICB), (pg8::bf16_t*)(ws + WS_G)},
                       {args.in[12], args.in[12] + 1024, args.in[14], args.in[14] + 1024, args.in[14]}};
        pg8::gemm_phase<pg8::EpiLora, pg8::GroupedOrder, true, true>(ring, g, S, E);
    }
    if (IN(5)) { FRESH_CTX(); phase_na_attention(args, c); }
    do { if ((IN(4) || IN(5)) && IN(6)) xcd_barrier(bar); } while (0);
    if (IN(6)) { FRESH_CTX(); phase_scan(args, c); } SEAM(6);
    if (IN(7)) { FRESH_CTX(); phase_scan_chain(args, c); } SEAM(7);
    if (IN(8)) { FRESH_CTX(); phase_scan_fix(args, c); } SEAM(8);
    if (IN(9)) { FRESH_CTX(); phase_rwkv_post(args, c); } SEAM(9);
    if (IN(10)) {
        pg8::Gemm g{(const pg8::bf16_t*)(ws + WS_OA), (const pg8::bf16_t*)(ws + WS_WA), MROWS, DM, 1024, (const pg8::bf16_t*)(ws + WS_OB16), (const pg8::bf16_t*)(ws + WS_WB), 0x76767676u, 0x7B7B7B7Bu};
        pg8::StaticOrder S; S.init(MROWS, DM, c.G, c.bid);
        pg8::EpiGate2 E{(pg8::bf16_t*)(ws + WS_MERGED), (const pg8::bf16_t*)args.out};
        pg8::gemm_phase<pg8::EpiGate2, pg8::StaticOrder, true, true, true, true>(ring, g, S, E);
    } SEAM(10);
    if (IN(11)) {
        pg8::Gemm g{(const pg8::bf16_t*)(ws + WS_MERGED), (const pg8::bf16_t*)(ws + WS_WOUT), MROWS, DM, DM / 2, nullptr, nullptr, 0x75757575u, 0x7A7A7A7Au}; pg8::StaticOrder S; S.init(MROWS, DM, c.G, c.bid);
        pg8::EpiRes E{args.in[0], args.out, mod + 4096, 12288};
        pg8::gemm_phase<pg8::EpiRes, pg8::StaticOrder, true, true, false, true>(ring, g, S, E);
    } SEAM(11);
    if (IN(12)) { FRESH_CTX(); phase_norm_mod<false>(c, args.out, args.in[5], mod, 6144, 8192, (bf16*)(ws + WS_U2)); } SEAM(12);
    if (IN(13)) {
        pg8::Gemm g{(const pg8::bf16_t*)(ws + WS_U2), (const pg8::bf16_t*)(ws + WS_WQS), MROWS, DM, DM}; pg8::StaticOrder S; S.init(MROWS, DM, c.G, c.bid);
        pg8::EpiRes E{nullptr, (float*)(ws + WS_SC), nullptr, 0};
        pg8::gemm_phase<pg8::EpiRes, pg8::StaticOrder, true, true>(ring, g, S, E);
    } SEAM(13);
    if (IN(14)) { FRESH_CTX(); phase_route(args, c); } SEAM(14);
    if (IN(15)) { FRESH_CTX(); phase_peer_u(args, c); } SEAM(15);
    if (IN(16)) { FRESH_CTX(); phase_peer_h(args, c); } SEAM(16);
    if (IN(17)) { FRESH_CTX(); phase_peer_v(args, c); }
#undef IN
#undef SEAM
}

extern "C" void kernel_launch(void* const* d_in, const int* in_sizes, int n_in, void* d_out, int out_size, void* d_ws, size_t ws_size, hipStream_t stream) {
    static int grid = 0;
    if (grid == 0) {
        if (n_in != 30 || in_sizes[0] != MROWS * DM || out_size != MROWS * DM || ws_size < WS_END) {
            fprintf(stderr, "kernel_launch: unexpected problem (n_in %d, in0 %d, out %d, ws %zu; need ws >= %zu); nothing launched\n", n_in, n_in > 0 ? in_sizes[0] : -1, out_size, ws_size, (size_t)WS_END); grid = -1; return; }
        int dev = 0, cus = 0, per_cu = 0;
        if (hipGetDevice(&dev) != hipSuccess || hipDeviceGetAttribute(&cus, hipDeviceAttributeMultiprocessorCount, dev) != hipSuccess) { fprintf(stderr, "kernel_launch: device query failed\n"); grid = -1; return; }
        if (hipFuncSetAttribute((const void*)hybrid_fwd, hipFuncAttributeMaxDynamicSharedMemorySize, LDS_BYTES) != hipSuccess) { fprintf(stderr, "kernel_launch: hipFuncSetAttribute failed\n"); grid = -1; return; }
        if (hipOccupancyMaxActiveBlocksPerMultiprocessor(&per_cu, (const void*)hybrid_fwd, NWAVES * 64, LDS_BYTES) != hipSuccess || per_cu < 1)
            fprintf(stderr, "kernel_launch: note: occupancy query reports %d workgroups per CU\n", per_cu);
        (void)hipGetLastError();
        grid = cus;
        if (grid > 256) grid = 256;
    }
    if (grid < 0) return;
    if (hipMemsetAsync((char*)d_ws + WS_CTL, 0, CTL_ZERO_BYTES, stream) != hipSuccess) { fprintf(stderr, "kernel_launch: memset failed\n"); return; }
    Args a{};
    for (int i = 0; i < 30; ++i) a.in[i] = (const float*)d_in[i];
    a.out = (float*)d_out; a.ws = (unsigned char*)d_ws;
#if MK_PER_PHASE
    for (int p = 0; p < N_PHASES; ++p) { a.ph_lo = p; a.ph_hi = p + 1; hipLaunchKernelGGL(hybrid_fwd, dim3(grid), dim3(NWAVES * 64), LDS_BYTES, stream, a); }
#else
    a.ph_lo = 0; a.ph_hi = N_PHASES;
    hipLaunchKernelGGL(hybrid_fwd, dim3(grid), dim3(NWAVES * 64), LDS_BYTES, stream, a);
#endif
    const hipError_t le = hipPeekAtLastError();
    if (le != hipSuccess) fprintf(stderr, "kernel_launch: launch failed: %s\n", hipGetErrorName(le));
}
```

```cpp
#include <hip/hip_runtime.h>
#include <cstdio>
#include <cstdint>
#ifndef MK_PER_PHASE
#define MK_PER_PHASE 0
#endif
#ifndef DUP_PHASE
#define DUP_PHASE -1
#endif
namespace pg8 {
#define PG8_LAS __attribute__((address_space(3)))
typedef unsigned short bf16_t;
typedef short bf16x8 __attribute__((ext_vector_type(8)));
typedef float f32x4 __attribute__((ext_vector_type(4)));
typedef unsigned u32x4 __attribute__((ext_vector_type(4)));
constexpr int BM = 256, BK = 64, HALF = 128, HTB = HALF * BK * 2  , STAGE_BYTES = 8 * HTB, NXCD = 8, WGM = 8;

__host__ __device__ __forceinline__ int lds_byte(int r, int c) { const int st = (r >> 4) * 2 + (c >> 5), rr = r & 15, cc = c & 31, ob = rr * 64 + cc * 2; return st * 1024 + (ob ^ (((ob >> 9) & 1) << 5)); }
__host__ __device__ __forceinline__ void stage_rc(int b, int& R, int& C) { const int st = b / 1024, sb = b % 1024, swz = sb ^ (((sb >> 9) & 1) << 5); R = (st >> 1) * 16 + swz / 64; C = (st & 1) * 32 + (swz % 64) / 2; }
__host__ __device__ __forceinline__ int perm32(int rho) { const int n = rho >> 4, i = rho & 15; return 8 * (i >> 2) + 4 * n + (i & 3); }

struct Unit { int pm, pn; };
struct Gemm { const bf16_t* A; const bf16_t* Bt; int M, N, K; const bf16_t* A2; const bf16_t* Bt2; unsigned f8sb, f8sa; };
typedef int i32x4 __attribute__((ext_vector_type(4)));
typedef int i32x8 __attribute__((ext_vector_type(8)));
__device__ __forceinline__ i32x8 cat8(bf16x8 a, bf16x8 b) { return __builtin_shufflevector(__builtin_bit_cast(i32x4, a), __builtin_bit_cast(i32x4, b), 0, 1, 2, 3, 4, 5, 6, 7); }

struct StaticOrder {
    int nM, nN, nwg, G, c;
    __host__ __device__ void init(int M, int N, int G_, int c_) { nM = M / BM; nN = N / BM; nwg = nM * nN; G = G_; c = c_; }
    __host__ __device__ bool next(int i, Unit& u) const {
        const long L = (long)i * G + c; if (L >= nwg) return false;
        int wgid = (int)L; { const int q = nwg / NXCD, r = nwg % NXCD, xcd = wgid % NXCD, off = wgid / NXCD; wgid = (xcd < r ? xcd * (q + 1) : r * (q + 1) + (xcd - r) * q) + off; }
        const int nig = WGM * nN, gid = wgid / nig, fm = gid * WGM, gsz = (nM - fm) < WGM ? (nM - fm) : WGM;
        u.pm = fm + ((wgid % nig) % gsz); u.pn = (wgid % nig) / gsz; return true;
    }
    __device__ __forceinline__ size_t a_off(const Unit&) const { return 0; }
    __device__ __forceinline__ void a_ready(const Unit&) const {}
    __device__ __forceinline__ void done(const Unit&) const {}
};
struct GroupedOrder : StaticOrder { size_t a_stride; __device__ __forceinline__ size_t a_off(const Unit& u) const { return (size_t)(u.pn >> 2) * a_stride; } };
__device__ __forceinline__ unsigned cvt_pk_bf16(float lo, float hi) { unsigned r; asm volatile("v_cvt_pk_bf16_f32 %0, %1, %2" : "=v"(r) : "v"(lo), "v"(hi)); return r; }
typedef float f32x2 __attribute__((ext_vector_type(2)));
__device__ __forceinline__ float sigm(float x) { return 1.0f / (1.0f + __expf(-x)); }
__device__ __forceinline__ float bflo(unsigned u) { return __uint_as_float(u << 16); }
__device__ __forceinline__ float bfhi(unsigned u) { return __uint_as_float(u & 0xffff0000u); }

typedef unsigned zu32x2 __attribute__((ext_vector_type(2)));
__device__ __forceinline__ float z448(float x) { return __builtin_amdgcn_fmed3f(x, -448.f, 448.f); }
struct EpiZ {
    static constexpr bool PERM = true, AFTER_DRAIN = false;
    bf16_t *ZA, *ZB, *ZG; const float* bgate;
    __device__ __forceinline__ void operator()(const f32x4 (&acc)[2][2][4][2], const Unit& u, int wr, int wc, int fr, int fq) const {
        const int row0 = u.pm * BM + wr * 64 + fr;
        bf16_t* base; int ldc, colt; bool gate = false;
        if (u.pn < 12) { base = ZA; ldc = 3072; colt = u.pn * 256; }
        else if (u.pn < 27) { base = ZB; ldc = 3840; colt = (u.pn - 12) * 256; }
        else { base = ZG; ldc = 4096; colt = (u.pn - 27) * 256; gate = true; }
        const int col0 = colt + wc * 32 + 8 * fq;
        f32x4 bv[2][2];
#pragma unroll
        for (int bj = 0; bj < 2; ++bj)
#pragma unroll
            for (int n = 0; n < 2; ++n) bv[bj][n] = gate ? *(const f32x4*)(bgate + col0 + bj * HALF + 4 * n) : (f32x4){0.f, 0.f, 0.f, 0.f};
#pragma unroll
        for (int ai = 0; ai < 2; ++ai)
#pragma unroll
            for (int m = 0; m < 4; ++m) { bf16_t* rowp = base + (size_t)(row0 + ai * HALF + m * 16) * ldc + col0;
#pragma unroll
                for (int bj = 0; bj < 2; ++bj) { f32x4 v0 = acc[ai][bj][m][0] + bv[bj][0], v1 = acc[ai][bj][m][1] + bv[bj][1];
                    if (gate) {
#pragma unroll
                        for (int j = 0; j < 4; ++j) { v0[j] = sigm(v0[j]); v1[j] = sigm(v1[j]); } }
                    if (base != ZA) {
                        const float sc_ = gate ? 256.f : 16.f; int t0 = 0, t1 = 0;
                        t0 = __builtin_amdgcn_cvt_pk_fp8_f32(z448(v0[0] * sc_), z448(v0[1] * sc_), t0, false); t0 = __builtin_amdgcn_cvt_pk_fp8_f32(z448(v0[2] * sc_), z448(v0[3] * sc_), t0, true);
                        t1 = __builtin_amdgcn_cvt_pk_fp8_f32(z448(v1[0] * sc_), z448(v1[1] * sc_), t1, false); t1 = __builtin_amdgcn_cvt_pk_fp8_f32(z448(v1[2] * sc_), z448(v1[3] * sc_), t1, true);
                        zu32x2 w8; w8.x = (unsigned)t0; w8.y = (unsigned)t1;
                        *(zu32x2*)((unsigned char*)base + (size_t)(row0 + ai * HALF + m * 16) * ldc + col0 + bj * HALF) = w8;
                    } else {
                    u32x4 w; w.x = cvt_pk_bf16(v0[0], v0[1]); w.y = cvt_pk_bf16(v0[2], v0[3]); w.z = cvt_pk_bf16(v1[0], v1[1]); w.w = cvt_pk_bf16(v1[2], v1[3]);
                    *(u32x4*)(rowp + bj * HALF) = w; } } }
    }
};
template <int MODE> struct EpiAct {
    static constexpr bool PERM = true, AFTER_DRAIN = false;
    bf16_t* O; int ldc; const float* bias;
    __device__ __forceinline__ void operator()(const f32x4 (&acc)[2][2][4][2], const Unit& u, int wr, int wc, int fr, int fq) const {
        const int row0 = u.pm * BM + wr * 64 + fr, col0 = u.pn * BM + wc * 32 + 8 * fq;
#pragma unroll
        for (int ai = 0; ai < 2; ++ai)
#pragma unroll
            for (int m = 0; m < 4; ++m) { bf16_t* rowp = O + (size_t)(row0 + ai * HALF + m * 16) * ldc + col0;
#pragma unroll
                for (int bj = 0; bj < 2; ++bj) { f32x4 v0 = acc[ai][bj][m][0], v1 = acc[ai][bj][m][1];
                    if (MODE != 0) { v0 += *(const f32x4*)(bias + col0 + bj * HALF); v1 += *(const f32x4*)(bias + col0 + bj * HALF + 4); }
                    if (MODE != 0) {
#pragma unroll
                        for (int j = 0; j < 4; ++j) { v0[j] = sigm(v0[j]); v1[j] = sigm(v1[j]); if (MODE == 2) { v0[j] *= -0.60653066f; v1[j] *= -0.60653066f; } } }
                    u32x4 w; w.x = cvt_pk_bf16(v0[0], v0[1]); w.y = cvt_pk_bf16(v0[2], v0[3]); w.z = cvt_pk_bf16(v1[0], v1[1]); w.w = cvt_pk_bf16(v1[2], v1[3]);
                    *(u32x4*)(rowp + bj * HALF) = w; } }
    }
};
template <bool ADD> struct EpiGate {
    static constexpr bool PERM = true, AFTER_DRAIN = false;
    bf16_t* O; const bf16_t* G; int gcol; const bf16_t* T;
    __device__ __forceinline__ void operator()(const f32x4 (&acc)[2][2][4][2], const Unit& u, int wr, int wc, int fr, int fq) const {
        const int row0 = u.pm * BM + wr * 64 + fr, col0 = u.pn * BM + wc * 32 + 8 * fq;
#pragma unroll
        for (int ai = 0; ai < 2; ++ai)
#pragma unroll
            for (int m = 0; m < 4; ++m) { const size_t r = (size_t)(row0 + ai * HALF + m * 16);
#pragma unroll
                for (int bj = 0; bj < 2; ++bj) { const int c = col0 + bj * HALF;
                    const u32x4 g = *(const u32x4*)(G + r * 4096 + gcol + c);
                    f32x4 v0 = acc[ai][bj][m][0], v1 = acc[ai][bj][m][1];
                    v0[0] *= bflo(g.x); v0[1] *= bfhi(g.x); v0[2] *= bflo(g.y); v0[3] *= bfhi(g.y); v1[0] *= bflo(g.z); v1[1] *= bfhi(g.z); v1[2] *= bflo(g.w); v1[3] *= bfhi(g.w);
                    if (ADD) { const u32x4 t = *(const u32x4*)(T + r * 2048 + c);
                        v0[0] += bflo(t.x); v0[1] += bfhi(t.x); v0[2] += bflo(t.y); v0[3] += bfhi(t.y); v1[0] += bflo(t.z); v1[1] += bfhi(t.z); v1[2] += bflo(t.w); v1[3] += bfhi(t.w); }
                    u32x4 w; w.x = cvt_pk_bf16(v0[0], v0[1]); w.y = cvt_pk_bf16(v0[2], v0[3]); w.z = cvt_pk_bf16(v1[0], v1[1]); w.w = cvt_pk_bf16(v1[2], v1[3]);
                    *(u32x4*)(O + r * 2048 + c) = w; } }
    }
};
struct EpiRes {
    static constexpr bool PERM = false, AFTER_DRAIN = false;
    const float* X; float* OUT; const float* gate; int gstride;
    __device__ __forceinline__ void operator()(const f32x4 (&acc)[2][2][4][2], const Unit& u, int wr, int wc, int fr, int fq) const {
        const int row0 = u.pm * BM + wr * 64 + fr, col0 = u.pn * BM + wc * 32 + 4 * fq;
        const int b = (u.pm >= 32) ? 1 : 0;
        f32x4 gv[2][2];
#pragma unroll
        for (int bj = 0; bj < 2; ++bj)
#pragma unroll
            for (int n = 0; n < 2; ++n) gv[bj][n] = X ? *(const f32x4*)(gate + (size_t)b * gstride + col0 + bj * HALF + n * 16) : (f32x4){1.f, 1.f, 1.f, 1.f};
#pragma unroll
        for (int ai = 0; ai < 2; ++ai)
#pragma unroll
            for (int m = 0; m < 4; ++m) { const size_t off = (size_t)(row0 + ai * HALF + m * 16) * 2048 + col0;
#pragma unroll
                for (int bj = 0; bj < 2; ++bj)
#pragma unroll
                    for (int n = 0; n < 2; ++n) { f32x4 o = acc[ai][bj][m][n] * gv[bj][n];
                        if (X) o += *(const f32x4*)(X + off + bj * HALF + n * 16);
                        *(f32x4*)(OUT + off + bj * HALF + n * 16) = o; } }
    }
};
struct EpiLora {
    static constexpr bool PERM = true, AFTER_DRAIN = false;
    bf16_t* O[5]; const float* bias[5];
    __device__ __forceinline__ void operator()(const f32x4 (&acc)[2][2][4][2], const Unit& u, int wr, int wc, int fr, int fq) const {
        const int grp = u.pn >> 2, mode = (grp < 2) ? 2 : ((grp < 4) ? 1 : 0);
        const int row0 = u.pm * BM + wr * 64 + fr, col0 = (u.pn & 3) * BM + wc * 32 + 8 * fq;
        bf16_t* Og = O[0]; const float* bg = bias[0];
        if (grp == 1) { Og = O[1]; bg = bias[1]; } else if (grp == 2) { Og = O[2]; bg = bias[2]; } else if (grp == 3) { Og = O[3]; bg = bias[3]; } else if (grp == 4) { Og = O[4]; bg = bias[4]; }
#pragma unroll
        for (int ai = 0; ai < 2; ++ai)
#pragma unroll
            for (int m = 0; m < 4; ++m) { bf16_t* rowp = Og + (size_t)(row0 + ai * HALF + m * 16) * 1024 + col0;
#pragma unroll
                for (int bj = 0; bj < 2; ++bj) { f32x4 v0 = acc[ai][bj][m][0], v1 = acc[ai][bj][m][1];
                    if (mode != 0) { v0 += *(const f32x4*)(bg + col0 + bj * HALF); v1 += *(const f32x4*)(bg + col0 + bj * HALF + 4);
                        const float sc = (mode == 2) ? -0.60653066f : 1.0f;
#pragma unroll
                        for (int j = 0; j < 4; ++j) { v0[j] = sigm(v0[j]) * sc; v1[j] = sigm(v1[j]) * sc; } }
                    u32x4 w; w.x = cvt_pk_bf16(v0[0], v0[1]); w.y = cvt_pk_bf16(v0[2], v0[3]); w.z = cvt_pk_bf16(v1[0], v1[1]); w.w = cvt_pk_bf16(v1[2], v1[3]);
                    *(u32x4*)(rowp + bj * HALF) = w; } }
    }
};
typedef unsigned u32x2 __attribute__((ext_vector_type(2)));
__device__ __forceinline__ float c448(float x) { return __builtin_amdgcn_fmed3f(x, -448.f, 448.f); }
struct EpiGate2 {
    static constexpr bool PERM = true, AFTER_DRAIN = false;
    bf16_t* O; const bf16_t* G;
    __device__ __forceinline__ void mid(f32x4 (&acc)[2][2][4][2], const Unit& u, int wr, int wc, int fr, int fq) const {
        const int row0 = u.pm * BM + wr * 64 + fr, col0 = u.pn * BM + wc * 32 + 8 * fq;
        unsigned off = (unsigned)(row0 * 4096 + col0);
        const char* Gb = (const char*)G;
#pragma unroll
        for (int ai = 0; ai < 2; ++ai)
#pragma unroll
            for (int m = 0; m < 4; ++m) {
#pragma unroll
                for (int bj = 0; bj < 2; ++bj) {
                    asm volatile("" : "+v"(off));
                    const zu32x2 ga = *(const zu32x2*)(Gb + off + bj * 128), gb = *(const zu32x2*)(Gb + off + bj * 128 + 2048);
                    f32x4& v0 = acc[ai][bj][m][0]; f32x4& v1 = acc[ai][bj][m][1];
                    { const auto a0 = __builtin_amdgcn_cvt_pk_f32_fp8((int)ga.x, false), a1 = __builtin_amdgcn_cvt_pk_f32_fp8((int)ga.x, true), a2 = __builtin_amdgcn_cvt_pk_f32_fp8((int)ga.y, false), a3 = __builtin_amdgcn_cvt_pk_f32_fp8((int)ga.y, true);
                      const auto b0 = __builtin_amdgcn_cvt_pk_f32_fp8((int)gb.x, false), b1 = __builtin_amdgcn_cvt_pk_f32_fp8((int)gb.x, true), b2 = __builtin_amdgcn_cvt_pk_f32_fp8((int)gb.y, false), b3 = __builtin_amdgcn_cvt_pk_f32_fp8((int)gb.y, true);
                      v0[0] *= a0[0] * __builtin_amdgcn_rcpf(fmaxf(b0[0], 0.001953125f)); v0[1] *= a0[1] * __builtin_amdgcn_rcpf(fmaxf(b0[1], 0.001953125f)); v0[2] *= a1[0] * __builtin_amdgcn_rcpf(fmaxf(b1[0], 0.001953125f)); v0[3] *= a1[1] * __builtin_amdgcn_rcpf(fmaxf(b1[1], 0.001953125f));
                      v1[0] *= a2[0] * __builtin_amdgcn_rcpf(fmaxf(b2[0], 0.001953125f)); v1[1] *= a2[1] * __builtin_amdgcn_rcpf(fmaxf(b2[1], 0.001953125f)); v1[2] *= a3[0] * __builtin_amdgcn_rcpf(fmaxf(b3[0], 0.001953125f)); v1[3] *= a3[1] * __builtin_amdgcn_rcpf(fmaxf(b3[1], 0.001953125f)); }
                    asm volatile("" : "+v"(v0), "+v"(v1));
                }
                off += (m == 3) ? (unsigned)((HALF - 48) * 4096) : (unsigned)(16 * 4096);
            }
        __builtin_amdgcn_sched_barrier(0);
    }
    __device__ __forceinline__ void operator()(const f32x4 (&acc)[2][2][4][2], const Unit& u, int wr, int wc, int fr, int fq) const {
        const int row0 = u.pm * BM + wr * 64 + fr, col0 = u.pn * BM + wc * 32 + 8 * fq;
#pragma unroll
        for (int ai = 0; ai < 2; ++ai)
#pragma unroll
            for (int m = 0; m < 4; ++m) { const size_t r = (size_t)(row0 + ai * HALF + m * 16);
#pragma unroll
                for (int bj = 0; bj < 2; ++bj) { const int c = col0 + bj * HALF;
                    const zu32x2 g = *(const zu32x2*)((const unsigned char*)G + r * 4096 + 2048 + c);
                    f32x4 v0 = acc[ai][bj][m][0], v1 = acc[ai][bj][m][1];
                    { const auto g0 = __builtin_amdgcn_cvt_pk_f32_fp8((int)g.x, false), g1 = __builtin_amdgcn_cvt_pk_f32_fp8((int)g.x, true), g2 = __builtin_amdgcn_cvt_pk_f32_fp8((int)g.y, false), g3 = __builtin_amdgcn_cvt_pk_f32_fp8((int)g.y, true);
                      const float k_ = 1.0f / 256.0f;
                      v0[0] *= fmaxf(g0[0], 0.001953125f) * k_; v0[1] *= fmaxf(g0[1], 0.001953125f) * k_; v0[2] *= fmaxf(g1[0], 0.001953125f) * k_; v0[3] *= fmaxf(g1[1], 0.001953125f) * k_;
                      v1[0] *= fmaxf(g2[0], 0.001953125f) * k_; v1[1] *= fmaxf(g2[1], 0.001953125f) * k_; v1[2] *= fmaxf(g3[0], 0.001953125f) * k_; v1[3] *= fmaxf(g3[1], 0.001953125f) * k_; }
                    int t0 = 0, t1 = 0;
                    t0 = __builtin_amdgcn_cvt_pk_fp8_f32(c448(v0[0] * 32.f), c448(v0[1] * 32.f), t0, false); t0 = __builtin_amdgcn_cvt_pk_fp8_f32(c448(v0[2] * 32.f), c448(v0[3] * 32.f), t0, true);
                    t1 = __builtin_amdgcn_cvt_pk_fp8_f32(c448(v1[0] * 32.f), c448(v1[1] * 32.f), t1, false); t1 = __builtin_amdgcn_cvt_pk_fp8_f32(c448(v1[2] * 32.f), c448(v1[3] * 32.f), t1, true);
                    u32x2 w; w.x = (unsigned)t0; w.y = (unsigned)t1;
                    *(u32x2*)((unsigned char*)O + r * 2048 + c) = w; } }
    }
};
template <class Epi, class Sched, bool ALIGN_EPI = false, bool SP2 = false, bool DUALK = false, bool F8 = false>
__device__ __forceinline__ void gemm_phase(PG8_LAS unsigned char* lds, const Gemm g, const Sched& S, const Epi& E) {
    int tid_ = threadIdx.x; asm volatile("" : "+v"(tid_));
    const int tid = tid_, wid = __builtin_amdgcn_readfirstlane(tid >> 6), lane = tid & 63, wr = wid >> 2, wc = wid & 3, fr = lane & 15, fq = lane >> 4;
    const int K = DUALK ? g.K / 2 : g.K, nt = g.K / BK, nth = nt / 2;
    unsigned voffA[2], voffB[2];
#pragma unroll
    for (int i = 0; i < 2; ++i) { int R, C; stage_rc(tid * 16 + i * 8192, R, C); const int Rb = Epi::PERM ? ((R & ~31) + perm32(R & 31)) : R;
        voffA[i] = (unsigned)(R * K + C) * 2u; voffB[i] = (unsigned)(Rb * K + C) * 2u; }
    const size_t kstep = (size_t)(BK * 2);
    const size_t hstep = (size_t)HALF * K * 2;
    const size_t tstep = 2 * hstep;
    const unsigned ldsw = (unsigned)wid * 1024u;
    const int aoff = lds_byte(wr * 64 + fr, fq * 8), boff = lds_byte(wc * 32 + fr, fq * 8);
#define PG8_SA(b, h) (((b) * 2 + (h)) * HTB)
#define PG8_SB(b, h) ((4 + (b) * 2 + (h)) * HTB)
#define PG8_STAGE(bufoff, gbase, voff) do { _Pragma("unroll") for (int _i = 0; _i < 2; ++_i) \
        __builtin_amdgcn_global_load_lds((const unsigned*)((const char*)(gbase) + (voff)[_i]), (PG8_LAS unsigned*)(lds + (bufoff) + ldsw + _i * 8192), 16, 0, 0); } while (0)
#define PG8_LDA(dst, b, h) do { _Pragma("unroll") for (int m = 0; m < 4; ++m) { \
        if constexpr (F8) dst##8[m] = cat8(*(const PG8_LAS bf16x8*)(lds + PG8_SA(b, h) + aoff + m * 2048), *(const PG8_LAS bf16x8*)(lds + PG8_SA(b, h) + aoff + m * 2048 + 1024)); \
        else { _Pragma("unroll") for (int k = 0; k < 2; ++k) dst[m][k] = *(const PG8_LAS bf16x8*)(lds + PG8_SA(b, h) + aoff + m * 2048 + k * 1024); } } } while (0)
#define PG8_LDB(dst, b, h) do { _Pragma("unroll") for (int n = 0; n < 2; ++n) { \
        if constexpr (F8) dst##8[n] = cat8(*(const PG8_LAS bf16x8*)(lds + PG8_SB(b, h) + boff + n * 2048), *(const PG8_LAS bf16x8*)(lds + PG8_SB(b, h) + boff + n * 2048 + 1024)); \
        else { _Pragma("unroll") for (int k = 0; k < 2; ++k) dst[n][k] = *(const PG8_LAS bf16x8*)(lds + PG8_SB(b, h) + boff + n * 2048 + k * 1024); } } } while (0)
#define PG8_MMA(ai, bj, At, Bt) do { __builtin_amdgcn_s_setprio(1); _Pragma("unroll") for (int m = 0; m < 4; ++m) _Pragma("unroll") for (int n = 0; n < 2; ++n) { \
        if constexpr (F8) asm volatile("v_mfma_scale_f32_16x16x128_f8f6f4 %0, %1, %2, %0, %3, %4 op_sel_hi:[0,0,0]" : "+v"(acc[ai][bj][m][n]) : "v"(Bt##8[n]), "v"(At##8[m]), "v"(f8sb_), "v"(f8sa_));     \
        else { _Pragma("unroll") for (int k = 0; k < 2; ++k) acc[ai][bj][m][n] = __builtin_amdgcn_mfma_f32_16x16x32_bf16(Bt[n][k], At[m][k], acc[ai][bj][m][n], 0, 0, 0); } } __builtin_amdgcn_s_setprio(0); } while (0)
#define PG8_WAIT_V(n) asm volatile("s_waitcnt vmcnt(" #n ")" ::: "memory")
#define PG8_WAIT_L(n) asm volatile("s_waitcnt lgkmcnt(" #n ")" ::: "memory")
#define PG8_BAR __builtin_amdgcn_s_barrier()
#define PG8_SCHED __builtin_amdgcn_sched_barrier(0)
    Unit cur, nxt; int ui = 0;
    if (!S.next(0, cur)) return;
    f32x4 acc[2][2][4][2];
#pragma unroll
    for (int a = 0; a < 2; ++a)
#pragma unroll
        for (int b = 0; b < 2; ++b)
#pragma unroll
            for (int m = 0; m < 4; ++m)
#pragma unroll
                for (int n = 0; n < 2; ++n) acc[a][b][m][n] = (f32x4){0.f, 0.f, 0.f, 0.f};
    const unsigned f8sb_ = g.f8sb, f8sa_ = g.f8sa;
    bf16x8 At[4][2], B0[2][2], B1[2][2]; i32x8 At8[4], B08[2], B18[2];
    const char* cA = (const char*)g.A + S.a_off(cur) + (size_t)cur.pm * tstep; const char* cB = (const char*)g.Bt + (size_t)cur.pn * tstep;
    const char* cA2 = DUALK ? (const char*)g.A2 + (size_t)cur.pm * tstep : cA; const char* cB2 = DUALK ? (const char*)g.Bt2 + (size_t)cur.pn * tstep : cB;
#define PG8_TA(tt) ((DUALK && (tt) >= nth) ? cA2 + (size_t)((tt) - nth) * kstep : cA + (size_t)(tt) * kstep)
#define PG8_TB(tt) ((DUALK && (tt) >= nth) ? cB2 + (size_t)((tt) - nth) * kstep : cB + (size_t)(tt) * kstep)
    S.a_ready(cur);
    if constexpr (SP2) {
        PG8_STAGE(PG8_SB(0, 0), cB, voffB); PG8_STAGE(PG8_SB(0, 1), cB + hstep, voffB); PG8_STAGE(PG8_SA(0, 0), cA, voffA); PG8_STAGE(PG8_SA(0, 1), cA + hstep, voffA);
        if (wr == 1) PG8_BAR;
        PG8_WAIT_V(2); PG8_BAR;
        PG8_STAGE(PG8_SB(1, 0), cB + kstep, voffB); PG8_STAGE(PG8_SA(1, 0), cA + kstep, voffA); PG8_STAGE(PG8_SB(1, 1), cB + hstep + kstep, voffB);
        PG8_WAIT_V(6); PG8_BAR;
    } else {
        PG8_STAGE(PG8_SB(0, 0), cB, voffB); PG8_STAGE(PG8_SA(0, 0), cA, voffA); PG8_STAGE(PG8_SB(0, 1), cB + hstep, voffB); PG8_STAGE(PG8_SA(0, 1), cA + hstep, voffA);
        if (wr == 1) PG8_BAR;
        PG8_WAIT_V(4); PG8_BAR;
        PG8_STAGE(PG8_SB(1, 0), cB + kstep, voffB); PG8_STAGE(PG8_SA(1, 0), cA + kstep, voffA); PG8_STAGE(PG8_SB(1, 1), cB + hstep + kstep, voffB);
        PG8_WAIT_V(6); PG8_BAR;
    }
    for (;;) {
        const bool has_next = S.next(ui + 1, nxt);
        const char* nA = has_next ? (const char*)g.A + S.a_off(nxt) + (size_t)nxt.pm * tstep : cA; const char* nB = has_next ? (const char*)g.Bt + (size_t)nxt.pn * tstep : cB;
        const char* nA2 = (DUALK && has_next) ? (const char*)g.A2 + (size_t)nxt.pm * tstep : cA2; const char* nB2 = (DUALK && has_next) ? (const char*)g.Bt2 + (size_t)nxt.pn * tstep : cB2;
        for (int t = 0; t < nt; t += 2) {
            const bool last = (t == nt - 2);
            const char* a1 = PG8_TA(t + 1);
            const char* a2 = last ? nA : PG8_TA(t + 2); const char* b2 = last ? nB : PG8_TB(t + 2);
            if constexpr (DUALK) { if (t == nth) { if constexpr (F8) { asm volatile("s_nop 15\n\ts_nop 15" ::: "memory"); } E.mid(acc, cur, wr, wc, fr, fq); } }
            const char* a3 = a2 + kstep; const char* b3 = b2 + kstep;
            if (last && has_next) S.a_ready(nxt);
            if constexpr (SP2) {
            PG8_LDB(B0, 0, 0); PG8_LDB(B1, 0, 1); PG8_SCHED; PG8_LDA(At, 0, 0); PG8_STAGE(PG8_SA(1, 1), a1 + hstep, voffA);
            PG8_WAIT_V(8); PG8_WAIT_L(0); PG8_BAR; PG8_MMA(0, 0, At, B0); PG8_MMA(0, 1, At, B1); PG8_BAR; PG8_SCHED;
            PG8_LDA(At, 0, 1); PG8_STAGE(PG8_SB(0, 0), b2, voffB); PG8_STAGE(PG8_SB(0, 1), b2 + hstep, voffB); PG8_STAGE(PG8_SA(0, 0), a2, voffA);
            PG8_WAIT_V(8); PG8_WAIT_L(0); PG8_BAR; PG8_MMA(1, 0, At, B0); PG8_MMA(1, 1, At, B1); PG8_BAR; PG8_SCHED;
            PG8_LDB(B0, 1, 0); PG8_LDB(B1, 1, 1); PG8_SCHED; PG8_LDA(At, 1, 0); PG8_STAGE(PG8_SA(0, 1), a2 + hstep, voffA);
            PG8_WAIT_V(8); PG8_WAIT_L(0); PG8_BAR; PG8_MMA(0, 0, At, B0); PG8_MMA(0, 1, At, B1); PG8_BAR; PG8_SCHED;
            PG8_LDA(At, 1, 1); PG8_STAGE(PG8_SB(1, 0), b3, voffB); PG8_STAGE(PG8_SB(1, 1), b3 + hstep, voffB); PG8_STAGE(PG8_SA(1, 0), a3, voffA);
            PG8_WAIT_V(8); PG8_WAIT_L(0); PG8_BAR; PG8_MMA(1, 0, At, B0); PG8_MMA(1, 1, At, B1); PG8_BAR; PG8_SCHED;
            } else {
            PG8_LDB(B0, 0, 0); PG8_SCHED; PG8_LDA(At, 0, 0); PG8_STAGE(PG8_SA(1, 1), a1 + hstep, voffA);
            PG8_WAIT_L(8); PG8_BAR; PG8_WAIT_L(0); PG8_MMA(0, 0, At, B0); PG8_BAR; PG8_SCHED;
            PG8_LDB(B1, 0, 1); PG8_STAGE(PG8_SB(0, 0), b2, voffB);
            PG8_BAR; PG8_WAIT_L(0); PG8_MMA(0, 1, At, B1); PG8_BAR;
            PG8_LDA(At, 0, 1); PG8_STAGE(PG8_SA(0, 0), a2, voffA);
            PG8_BAR; PG8_WAIT_L(0); PG8_MMA(1, 0, At, B0); PG8_BAR; PG8_SCHED;
            PG8_STAGE(PG8_SB(0, 1), b2 + hstep, voffB);
            PG8_WAIT_V(6); PG8_BAR; PG8_MMA(1, 1, At, B1); PG8_BAR;
            PG8_LDB(B0, 1, 0); PG8_SCHED; PG8_LDA(At, 1, 0); PG8_STAGE(PG8_SA(0, 1), a2 + hstep, voffA);
            PG8_WAIT_L(8); PG8_BAR; PG8_WAIT_L(0); PG8_MMA(0, 0, At, B0); PG8_BAR; PG8_SCHED;
            PG8_LDB(B1, 1, 1); PG8_STAGE(PG8_SB(1, 0), b3, voffB);
            PG8_BAR; PG8_WAIT_L(0); PG8_MMA(0, 1, At, B1); PG8_BAR;
            PG8_LDA(At, 1, 1); PG8_STAGE(PG8_SA(1, 0), a3, voffA);
            PG8_BAR; PG8_WAIT_L(0); PG8_MMA(1, 0, At, B0); PG8_BAR; PG8_SCHED;
            PG8_STAGE(PG8_SB(1, 1), b3 + hstep, voffB);
            PG8_WAIT_V(6); PG8_BAR; PG8_MMA(1, 1, At, B1); PG8_BAR;
            }
        }
        if constexpr (ALIGN_EPI) { if (wr == 0) PG8_BAR; }
        if constexpr (F8) { asm volatile("s_nop 15\n\ts_nop 15" ::: "memory"); }
        if constexpr (!Epi::AFTER_DRAIN) { E(acc, cur, wr, wc, fr, fq); S.done(cur); }
        if (!has_next) break;
#pragma unroll
        for (int a = 0; a < 2; ++a)
#pragma unroll
            for (int b = 0; b < 2; ++b)
#pragma unroll
                for (int m = 0; m < 4; ++m)
#pragma unroll
                    for (int n = 0; n < 2; ++n) acc[a][b][m][n] = (f32x4){0.f, 0.f, 0.f, 0.f};
        cur = nxt; cA = nA; cB = nB; cA2 = nA2; cB2 = nB2; ++ui;
        if constexpr (ALIGN_EPI) { if (wr == 1) PG8_BAR; }
    }
    PG8_WAIT_V(0);
    if constexpr (!ALIGN_EPI) { if (wr == 0) PG8_BAR; }
    PG8_BAR;
    if constexpr (Epi::AFTER_DRAIN) { E.fused(acc, cur, wr, wc, fr, fq, lds, wid, lane); S.done(cur); }
#undef PG8_TA
#undef PG8_TB
#undef PG8_SA
#undef PG8_SB
#undef PG8_STAGE
#undef PG8_LDA
#undef PG8_LDB
#undef PG8_MMA
#undef PG8_WAIT_V
#undef PG8_WAIT_L
#undef PG8_BAR
#undef PG8_SCHED
}
}

constexpr int NWAVES = 8;
constexpr int DM = 2048, SEQ = 8192, MROWS = 16384;
constexpr int NZ = 11008;
constexpr int N_PHASES = 18;
constexpr size_t MiB = 1ull << 20;
constexpr size_t WS_CTL = 0, CTL_ZERO_BYTES = 1 * MiB;
constexpr int CW_BAR = 4096;
constexpr size_t WS_MOD = 256 * 1024;
constexpr size_t WS_LORA = 2 * MiB;
constexpr size_t WS_WA = 5 * MiB, WS_WB = 9 * MiB, WS_WOUT = 13 * MiB, WS_WQS = 21 * MiB;
constexpr size_t WS_WIN = 29 * MiB;
constexpr size_t WS_U16 = 72 * MiB;
constexpr size_t WS_ZA = 136 * MiB;
constexpr size_t WS_ZB = 232 * MiB;
constexpr size_t WS_R = 352 * MiB, WS_K = 384 * MiB, WS_V = 416 * MiB, WS_KK = 448 * MiB;
constexpr size_t WS_OA = 29 * MiB;
constexpr size_t WS_T = 72 * MiB;
constexpr size_t WS_LWF = 232 * MiB, WS_LWB = 264 * MiB, WS_ICF = 296 * MiB, WS_ICB = 512 * MiB, WS_G = 544 * MiB;
constexpr size_t WS_OF = 72 * MiB, WS_OBW = 104 * MiB;
constexpr size_t WS_OB16 = 296 * MiB;
constexpr size_t WS_TMPA = 352 * MiB, WS_MERGED = 416 * MiB;
constexpr size_t WS_U2 = 72 * MiB;
constexpr size_t WS_PU = 136 * MiB, WS_PV = 168 * MiB;
constexpr size_t WS_EIDX = 29 * MiB, WS_ESU = 37 * MiB, WS_EGV = 45 * MiB;
constexpr size_t WS_PSC = 200 * MiB;
constexpr size_t WS_HP = 264 * MiB;
constexpr size_t WS_GVP = 53 * MiB;
constexpr size_t WS_SC = 264 * MiB;
constexpr size_t WS_VT = 480 * MiB;
constexpr size_t WS_PHIF = 576 * MiB, WS_PHIB = 328 * MiB;
constexpr size_t WS_QS = 61 * MiB, WS_PS = 65 * MiB, WS_SST = 69 * MiB;
constexpr size_t WS_X8H = 416 * MiB, WS_X8L = 448 * MiB;
constexpr size_t WS_END = 600 * MiB;
constexpr int LDS_BYTES = 163840, MISC_OFF = 157696;

#define GAS __attribute__((address_space(1)))
#define LAS __attribute__((address_space(3)))
#define DI __device__ __forceinline__
typedef unsigned short bf16;
typedef unsigned v4u __attribute__((ext_vector_type(4)));
typedef unsigned v2u __attribute__((ext_vector_type(2)));
typedef float f32x4 __attribute__((ext_vector_type(4)));
#define LDS_WAIT() asm volatile("s_waitcnt lgkmcnt(0)" ::: "memory")
DI unsigned f2bf(float f) { unsigned u = __builtin_bit_cast(unsigned, f); return (u + 0x7fffu + ((u >> 16) & 1u)) >> 16; }
DI unsigned pk2(float lo, float hi) { return f2bf(lo) | (f2bf(hi) << 16); }
DI float bflo(unsigned u) { return __uint_as_float(u << 16); }
DI float bfhi(unsigned u) { return __uint_as_float(u & 0xffff0000u); }
DI float sigm(float x) { return 1.0f / (1.0f + __expf(-x)); }
DI float wave_sum(float v) {
#pragma unroll
    for (int o = 32; o >= 1; o >>= 1) v += __shfl_xor(v, o);
    return v;
}
DI float wave_max(float v) {
#pragma unroll
    for (int o = 32; o >= 1; o >>= 1) v = fmaxf(v, __shfl_xor(v, o));
    return v;
}
template <int CTRL> DI float dpp_mov(float v) { return __int_as_float(__builtin_amdgcn_update_dpp(0, __float_as_int(v), CTRL, 0xF, 0xF, false)); }
DI float row16_sum(float v) { v += dpp_mov<0xB1>(v); v += dpp_mov<0x4E>(v); v += dpp_mov<0x124>(v); v += dpp_mov<0x128>(v); return v; }
template <int CTRL> DI float dpp_maxf(float v) { return fmaxf(v, dpp_mov<CTRL>(v)); }
DI float row16_max(float v) { v = dpp_maxf<0xB1>(v); v = dpp_maxf<0x4E>(v); v = dpp_maxf<0x124>(v); v = dpp_maxf<0x128>(v); return v; }
DI float rdl(float v, int l) { return __uint_as_float(__builtin_amdgcn_readlane(__float_as_uint(v), l)); }
DI float wave_sum_fast(float v) { v = row16_sum(v); return (rdl(v, 0) + rdl(v, 16)) + (rdl(v, 32) + rdl(v, 48)); }
DI float wave_max_fast(float v) { v = row16_max(v); return fmaxf(fmaxf(rdl(v, 0), rdl(v, 16)), fmaxf(rdl(v, 32), rdl(v, 48))); }
typedef float f32x2 __attribute__((ext_vector_type(2)));
template <int CTRL> DI float dpp_addf(float v) { return v + dpp_mov<CTRL>(v); }
DI float group8_sum(float v) { v = dpp_addf<0xB1>(v); v = dpp_addf<0x4E>(v); v = dpp_addf<0x141>(v); return v; }
#define XB_TMO      128
#define XB_XCNT(j)  (256  + 64 * (j))
#define XB_XSUB(j)  (1280 + 64 * (j))
#define XB_XGEN(j)  (2304 + 64 * (j))
#define XB_TOP      3328
#define XB_TOPGEN   3392
#define XCD_BAR_WORDS 3456
#define XB_SPIN_CAP (1u << 18)

__device__ __forceinline__ unsigned xb_ld(unsigned* p)              { return __hip_atomic_load(p, __ATOMIC_RELAXED, __HIP_MEMORY_SCOPE_AGENT); }
__device__ __forceinline__ unsigned xb_add(unsigned* p, unsigned v) { return __hip_atomic_fetch_add(p, v, __ATOMIC_RELAXED, __HIP_MEMORY_SCOPE_AGENT); }
__device__ __forceinline__ unsigned xb_xcc_id() { return (unsigned)__builtin_amdgcn_s_getreg((3 << 11) | 20) & 0xFu; }
#define XB_SPIN(cond, bar) do { unsigned _sp = 0; while (cond) { __builtin_amdgcn_s_sleep(1); \
    if ((++_sp & 255u) == 0u) { if (xb_ld(&(bar)[XB_TMO])) break; if (_sp > XB_SPIN_CAP) { atomicAdd(&(bar)[XB_TMO], 1u); break; } } } } while (0)

struct XcdBarrier {
    unsigned* bar; unsigned x;
    volatile LAS unsigned* st;
};

__device__ __forceinline__ XcdBarrier xcd_barrier_post(unsigned* bar, volatile LAS unsigned* st) {
    XcdBarrier b; b.bar = bar; b.x = xb_xcc_id(); b.st = st;
    if (threadIdx.x == 0) (void)xb_add(&bar[XB_XCNT(b.x)], 1u);
    return b;
}
__device__ __forceinline__ void xcd_barrier_complete(unsigned* bar, unsigned x, unsigned& nloc, unsigned& nx) {
    const unsigned G = gridDim.x * gridDim.y * gridDim.z;
    unsigned sum, cnt, mine, sp = 0u;
    for (;;) {
        sum = 0u; cnt = 0u; mine = 0u;
#pragma unroll
        for (unsigned j = 0; j < 16; ++j) { const unsigned c = xb_ld(&bar[XB_XCNT(j)]); sum += c; cnt += (c > 0u) ? 1u : 0u; mine = (j == x) ? c : mine; }
        if (sum == G) break;
        __builtin_amdgcn_s_sleep(1);
        if ((++sp & 255u) == 0u) { if (xb_ld(&bar[XB_TMO])) break; if (sp > XB_SPIN_CAP) { atomicAdd(&bar[XB_TMO], 1u); break; } }
    }
    nloc = mine > 0u ? mine : 1u; nx = cnt > 0u ? cnt : 1u;
}

__device__ __forceinline__ void xcd_barrier(const XcdBarrier& b) {
    asm volatile("s_waitcnt vmcnt(0)" ::: "memory");
    __syncthreads();
    if (threadIdx.x == 0) {
        unsigned* bar = b.bar;
        __builtin_amdgcn_s_waitcnt(0);
        unsigned nloc = b.st[0], nx = b.st[1];
        if (nloc == 0u) { xcd_barrier_complete(bar, b.x, nloc, nx); b.st[0] = nloc; b.st[1] = nx; }
        const unsigned old = xb_add(&bar[XB_XSUB(b.x)], 1u);
        const unsigned gen = old / nloc;
        if (old + 1u == (gen + 1u) * nloc) {
            __builtin_amdgcn_fence(__ATOMIC_RELEASE, "agent");
            asm volatile("s_waitcnt vmcnt(0)" ::: "memory");
            const unsigned og = xb_add(&bar[XB_TOP], 1u);
            const unsigned tg = og / nx;
            if (og + 1u == (tg + 1u) * nx) xb_add(&bar[XB_TOPGEN], 1u);
            else XB_SPIN(xb_ld(&bar[XB_TOPGEN]) == tg, bar);
            __builtin_amdgcn_fence(__ATOMIC_ACQUIRE, "agent");
            xb_add(&bar[XB_XGEN(b.x)], 1u);
            asm volatile("s_waitcnt vmcnt(0)" ::: "memory");
        } else {
            XB_SPIN(xb_ld(&bar[XB_XGEN(b.x)]) == gen, bar);
            __builtin_amdgcn_fence(__ATOMIC_ACQUIRE, "agent");
            asm volatile("s_waitcnt vmcnt(0)" ::: "memory");
        }
    }
    __syncthreads();
}

struct Args { const float* in[30]; float* out; unsigned char* ws; int ph_lo, ph_hi; };
struct Ctx { LAS unsigned char* lds; int tid, lane, wave, bid, G, gw, NGW; };

DI float c448(float x) { return __builtin_amdgcn_fmed3f(x, -448.f, 448.f); }
DI void p0_transpose_item(const float* W, int K, int N, bf16* WT, int pad_from, int pad_rows, LAS float* scr, int item, int lane, float qs = 0.f) {
    const int nblk = N / 64, kb = item / nblk, nb = item % nblk, k0 = 64 * kb, n0 = 64 * nb;
    const int row_off = (n0 >= pad_from) ? pad_rows : 0;
    const int kr = lane >> 4, n4 = (lane & 15) * 4;
    f32x4 v[16];
#pragma unroll
    for (int i = 0; i < 16; ++i) v[i] = *(const f32x4*)(W + (size_t)(k0 + 4 * i + kr) * N + n0 + n4);
#pragma unroll
    for (int i = 0; i < 16; ++i) { LAS float* d = scr + (4 * i + kr) * 65 + n4; d[0] = v[i].x; d[1] = v[i].y; d[2] = v[i].z; d[3] = v[i].w; }
    LDS_WAIT(); asm volatile("" ::: "memory");
    const int kc = lane & 7, nr = lane >> 3;
#pragma unroll
    for (int j = 0; j < 8; ++j) { const int n = nr + 8 * j; const LAS float* sp = scr + (8 * kc) * 65 + n;
        if (qs != 0.f) { int t0 = 0, t1 = 0;
            t0 = __builtin_amdgcn_cvt_pk_fp8_f32(c448(sp[0 * 65] * qs), c448(sp[1 * 65] * qs), t0, false); t0 = __builtin_amdgcn_cvt_pk_fp8_f32(c448(sp[2 * 65] * qs), c448(sp[3 * 65] * qs), t0, true);
            t1 = __builtin_amdgcn_cvt_pk_fp8_f32(c448(sp[4 * 65] * qs), c448(sp[5 * 65] * qs), t1, false); t1 = __builtin_amdgcn_cvt_pk_fp8_f32(c448(sp[6 * 65] * qs), c448(sp[7 * 65] * qs), t1, true);
            v2u o; o.x = (unsigned)t0; o.y = (unsigned)t1;
            *(GAS v2u*)((unsigned char*)WT + (size_t)(row_off + n0 + n) * K + k0 + 8 * kc) = o; }
        else {
        v4u o; o.x = pk2(sp[0 * 65], sp[1 * 65]); o.y = pk2(sp[2 * 65], sp[3 * 65]); o.z = pk2(sp[4 * 65], sp[5 * 65]); o.w = pk2(sp[6 * 65], sp[7 * 65]);
        *(GAS v4u*)(WT + (size_t)(row_off + n0 + n) * K + k0 + 8 * kc) = o; } }
    LDS_WAIT(); asm volatile("" ::: "memory");
}
DI void phase_prologue(const Args& a, const Ctx& c) {
    unsigned char* ws = a.ws;
    {
        LAS float* scr = (LAS float*)(c.lds + c.wave * 16640);
        constexpr int I_IN = 32 * 170, I_A = 16 * 32, I_O = 32 * 32;
        for (int it = c.gw; it < I_IN + 2 * I_A + I_O; it += c.NGW) {
            int r = it;
            if (r < I_IN) { p0_transpose_item(a.in[6], 2048, 10880, (bf16*)(ws + WS_WIN), 6784, 128, scr, r, c.lane, 1024.f); continue; } r -= I_IN;
            if (r < I_A) { p0_transpose_item(a.in[22], 1024, 2048, (bf16*)(ws + WS_WA), 1 << 30, 0, scr, r, c.lane, 512.f); continue; } r -= I_A;
            if (r < I_A) { p0_transpose_item(a.in[23], 1024, 2048, (bf16*)(ws + WS_WB), 1 << 30, 0, scr, r, c.lane, 512.f); continue; } r -= I_A;
            p0_transpose_item(a.in[24], 2048, 2048, (bf16*)(ws + WS_WOUT), 1 << 30, 0, scr, r, c.lane, 1024.f);
        }
    }
    const int gt = c.bid * 512 + c.tid, NGT = c.G * 512;
    for (int i = gt; i < 128 * 2048 / 16; i += NGT) *(GAS v4u*)(ws + WS_WIN + (size_t)6784 * 2048 + (size_t)i * 16) = (v4u){0u, 0u, 0u, 0u};
    for (int ch = gt; ch < 5 * 1024 * 32; ch += NGT) {
        const int g = ch >> 15, n = (ch >> 5) & 1023, k0 = (ch & 31) * 8;
        float v[8];
#pragma unroll
        for (int e = 0; e < 8; ++e) { const int k = k0 + e; float x = 0.f;
            if (g < 2) { if (k < 96) x = a.in[13][(size_t)(g * 96 + k) * 1024 + n]; }
            else if (g < 4) { if (k < 96) x = a.in[15][(size_t)((g - 2) * 96 + k) * 1024 + n]; }
            else x = a.in[16][(size_t)k * 1024 + n];
            v[e] = x; }
        v4u o; o.x = pk2(v[0], v[1]); o.y = pk2(v[2], v[3]); o.z = pk2(v[4], v[5]); o.w = pk2(v[6], v[7]);
        *(GAS v4u*)((bf16*)(ws + WS_LORA) + (size_t)g * 1024 * 256 + (size_t)n * 256 + k0) = o;
    }
    __syncthreads();
    {
        LAS float* subl = (LAS float*)c.lds;
        LAS float* wql = (LAS float*)(c.lds + 66048);
        const int n = c.tid & 127, mg = c.tid >> 7;
        int cur_half = -1;
        for (int item = c.bid; item < 1024; item += c.G) {
            const int seg = item >> 6, mblk = item & 63, half = seg & 1;
            if (half != cur_half) {
                __syncthreads();
                const float* sub = half ? a.in[27] : a.in[26];
                for (int i = 0; i < 32; ++i) { const int idx = c.tid + 512 * i; subl[(idx >> 7) * 129 + (idx & 127)] = sub[idx]; }
                cur_half = half;
            }
            for (int i = 0; i < 8; ++i) { const int idx = c.tid + 512 * i; wql[idx] = a.in[25][(size_t)(mblk * 32 + (idx >> 7)) * 2048 + seg * 128 + (idx & 127)]; }
            __syncthreads();
            float acc[8];
#pragma unroll
            for (int j = 0; j < 8; ++j) acc[j] = 0.f;
            for (int d = 0; d < 128; d += 4) {
                const float s0 = subl[n * 129 + d], s1 = subl[n * 129 + d + 1], s2 = subl[n * 129 + d + 2], s3 = subl[n * 129 + d + 3];
#pragma unroll
                for (int j = 0; j < 8; ++j) { const f32x4 w = *(const LAS f32x4*)(wql + (mg * 8 + j) * 128 + d); acc[j] += s0 * w.x + s1 * w.y + s2 * w.z + s3 * w.w; }
            }
            v4u o; o.x = pk2(acc[0], acc[1]); o.y = pk2(acc[2], acc[3]); o.z = pk2(acc[4], acc[5]); o.w = pk2(acc[6], acc[7]);
            *(GAS v4u*)((bf16*)(ws + WS_WQS) + (size_t)(seg * 128 + n) * 2048 + mblk * 32 + mg * 8) = o;
            __syncthreads();
        }
    }
    {
        float* mod = (float*)(ws + WS_MOD);
        LAS float* red = (LAS float*)c.lds;
        const int c4 = c.tid & 15, kg = c.tid >> 4;
        for (int sl = c.bid; sl < 192; sl += c.G) {
            const float* wp = a.in[2] + sl * 64 + c4 * 4;
            f32x4 a0 = (f32x4){0.f, 0.f, 0.f, 0.f}, a1 = a0;
#pragma unroll 8
            for (int i = 0; i < 64; ++i) { const int k = kg + 32 * i;
                const float c0 = a.in[1][k], c1 = a.in[1][2048 + k];
                const float s0 = c0 * sigm(c0), s1 = c1 * sigm(c1);
                const f32x4 w = *(const f32x4*)(wp + (size_t)k * 12288);
                a0 += w * s0; a1 += w * s1; }
            __syncthreads();
            *(LAS f32x4*)(red + (kg * 16 + c4) * 8) = a0; *(LAS f32x4*)(red + (kg * 16 + c4) * 8 + 4) = a1;
            __syncthreads();
            if (c.tid < 128) { const int q = c.tid >> 3, j = c.tid & 7; float sum = 0.f;
                for (int g = 0; g < 32; ++g) sum += red[(g * 16 + q) * 8 + j];
                const int col = sl * 64 + q * 4 + (j & 3);
                mod[(size_t)(j >> 2) * 12288 + col] = sum + a.in[3][col]; }
            __syncthreads();
        }
    }
}

template <bool Q8> DI void phase_norm_mod(const Ctx& c, const float* x, const float* nw, const float* mod, int shift_off, int scale_off, bf16* dst) {
    int cur_b = -1; f32x4 wg[8], sf[8];
    for (int rp = c.gw; rp < MROWS / 2; rp += c.NGW) {
        const int b = (2 * rp) >> 13;
        f32x4 v[2][8]; float ss[2];
#pragma unroll
        for (int z = 0; z < 2; ++z) { const f32x4* xr = (const f32x4*)(x + (size_t)(2 * rp + z) * DM) + c.lane;
#pragma unroll
            for (int j = 0; j < 8; ++j) v[z][j] = xr[64 * j]; }
#pragma unroll
        for (int z = 0; z < 2; ++z) { float q = 0.f;
#pragma unroll
            for (int j = 0; j < 8; ++j) q += (v[z][j].x * v[z][j].x + v[z][j].y * v[z][j].y) + (v[z][j].z * v[z][j].z + v[z][j].w * v[z][j].w);
            ss[z] = rsqrtf(wave_sum_fast(q) * (1.0f / DM) + 1e-6f); }
        if (b != cur_b) { cur_b = b;
            const f32x4* wv = (const f32x4*)nw + c.lane;
            const f32x4* sh = (const f32x4*)(mod + (size_t)b * 12288 + shift_off) + c.lane;
            const f32x4* sc = (const f32x4*)(mod + (size_t)b * 12288 + scale_off) + c.lane;
#pragma unroll
            for (int j = 0; j < 8; ++j) { wg[j] = wv[64 * j] * (sc[64 * j] + 1.0f); sf[j] = sh[64 * j]; } }
#pragma unroll
        for (int j = 0; j < 8; ++j) { const f32x4 w = wg[j], s = sf[j];
#pragma unroll
            for (int z = 0; z < 2; ++z) { const f32x4 y = (v[z][j] * ss[z]) * w + s;
                if (Q8) { int t = 0; t = __builtin_amdgcn_cvt_pk_fp8_f32(c448(y.x * 8.f), c448(y.y * 8.f), t, false); t = __builtin_amdgcn_cvt_pk_fp8_f32(c448(y.z * 8.f), c448(y.w * 8.f), t, true);
                    ((unsigned*)((unsigned char*)dst + (size_t)(2 * rp + z) * DM) + c.lane)[64 * j] = (unsigned)t; }
                else { v2u p; p.x = pk2(y.x, y.y); p.y = pk2(y.z, y.w); ((v2u*)(dst + (size_t)(2 * rp + z) * DM) + c.lane)[64 * j] = p; } } }
    }
}

DI void phase_qknorm_prep(const Args& a, const Ctx& c) {
    unsigned char* ws = a.ws;
    bf16* ZA = (bf16*)(ws + WS_ZA); const bf16* ZB = (const bf16*)(ws + WS_ZB);
    bf16* R16 = (bf16*)(ws + WS_R); bf16* K16 = (bf16*)(ws + WS_K); bf16* V16 = (bf16*)(ws + WS_V); bf16* KK16 = (bf16*)(ws + WS_KK);
    bf16* T = (bf16*)(ws + WS_T);
    const float* mu0 = a.in[11]; const float* mu1 = a.in[11] + 3712;
    for (int row = c.gw; row < MROWS; row += c.NGW) {
        {
            bf16* zr = ZA + (size_t)row * 3072;
#pragma unroll
            for (int cc = 0; cc < 4; ++cc) {
                const int col = cc * 512 + c.lane * 8;
                const v4u u = *(const v4u*)(zr + col);
                float v[8] = {bflo(u.x), bfhi(u.x), bflo(u.y), bfhi(u.y), bflo(u.z), bfhi(u.z), bflo(u.w), bfhi(u.w)};
                float ss = 0.f;
#pragma unroll
                for (int e = 0; e < 8; ++e) ss += v[e] * v[e];
                ss += __shfl_xor(ss, 1); ss += __shfl_xor(ss, 2); ss += __shfl_xor(ss, 4); ss += __shfl_xor(ss, 8);
                const bool isq = cc < 2;
                const float rstd = rsqrtf(ss * (1.0f / 128.0f) + 1e-6f) * (isq ? 0.08838834764831845f : 1.0f);
                const float* wn = (isq ? a.in[8] : a.in[9]) + (c.lane & 15) * 8;
#pragma unroll
                for (int e = 0; e < 8; ++e) v[e] = v[e] * rstd * wn[e];
                v4u o; o.x = pk2(v[0], v[1]); o.y = pk2(v[2], v[3]); o.z = pk2(v[4], v[5]); o.w = pk2(v[6], v[7]);
                *(v4u*)(zr + col) = o;
            }
        }
        {
            const int t = row & (SEQ - 1);
            const bool hp = t > 0, hn = t < SEQ - 1;
            const unsigned char* zc = (const unsigned char*)ZB + (size_t)row * 3840;
#pragma unroll
            for (int p = 0; p < 4; ++p) {
                const bool act = (p < 3) || (c.lane < 40);
                const int col = act ? (p * 1024 + c.lane * 16) : 0;
                const v4u uc = *(const v4u*)(zc + col);
                v4u up = (v4u){0u, 0u, 0u, 0u}, un = up;
                if (hp) up = *(const v4u*)(zc - 3840 + col);
                if (hn) un = *(const v4u*)(zc + 3840 + col);
                const unsigned wc4[4] = {uc.x, uc.y, uc.z, uc.w}, wp4[4] = {up.x, up.y, up.z, up.w}, wn4[4] = {un.x, un.y, un.z, un.w};
                float zs[16];
#pragma unroll
                for (int q = 0; q < 4; ++q) {
                    const f32x4 m0 = *(const f32x4*)(mu0 + col + 4 * q), m1 = *(const f32x4*)(mu1 + col + 4 * q);
                    const f32x2 c0 = __builtin_amdgcn_cvt_pk_f32_fp8((int)wc4[q], false), c1 = __builtin_amdgcn_cvt_pk_f32_fp8((int)wc4[q], true);
                    const f32x2 p0 = __builtin_amdgcn_cvt_pk_f32_fp8((int)wp4[q], false), p1 = __builtin_amdgcn_cvt_pk_f32_fp8((int)wp4[q], true);
                    const f32x2 n0 = __builtin_amdgcn_cvt_pk_f32_fp8((int)wn4[q], false), n1 = __builtin_amdgcn_cvt_pk_f32_fp8((int)wn4[q], true);
                    zs[4 * q] = (c0.x + m0.x * (p0.x - c0.x) + m1.x * (n0.x - c0.x)) * 0.0625f; zs[4 * q + 1] = (c0.y + m0.y * (p0.y - c0.y) + m1.y * (n0.y - c0.y)) * 0.0625f;
                    zs[4 * q + 2] = (c1.x + m0.z * (p1.x - c1.x) + m1.z * (n1.x - c1.x)) * 0.0625f; zs[4 * q + 3] = (c1.y + m0.w * (p1.y - c1.y) + m1.w * (n1.y - c1.y)) * 0.0625f;
                }
                v4u o8;
                { int t_[4];
#pragma unroll
                  for (int q = 0; q < 4; ++q) { t_[q] = 0; t_[q] = __builtin_amdgcn_cvt_pk_fp8_f32(c448(zs[4 * q] * 16.f), c448(zs[4 * q + 1] * 16.f), t_[q], false); t_[q] = __builtin_amdgcn_cvt_pk_fp8_f32(c448(zs[4 * q + 2] * 16.f), c448(zs[4 * q + 3] * 16.f), t_[q], true); }
                  o8.x = (unsigned)t_[0]; o8.y = (unsigned)t_[1]; o8.z = (unsigned)t_[2]; o8.w = (unsigned)t_[3]; }
                if (p == 0) { *(v4u*)((unsigned char*)R16 + (size_t)row * 1024 + col) = o8; }
                else if (p == 1) {
                    const int kc = col - 1024;
                    *(v4u*)((unsigned char*)K16 + (size_t)row * 1024 + kc) = o8;
                    float kx[16]; float ss = 0.f;
#pragma unroll
                    for (int q = 0; q < 4; ++q) { const f32x4 ka = *(const f32x4*)(a.in[17] + kc + 4 * q);
                        kx[4 * q] = zs[4 * q] * ka.x; kx[4 * q + 1] = zs[4 * q + 1] * ka.y; kx[4 * q + 2] = zs[4 * q + 2] * ka.z; kx[4 * q + 3] = zs[4 * q + 3] * ka.w; }
#pragma unroll
                    for (int e = 0; e < 16; ++e) ss += kx[e] * kx[e];
                    ss += __shfl_xor(ss, 1); ss += __shfl_xor(ss, 2);
                    const float inv = 1.0f / fmaxf(sqrtf(ss), 1e-12f);
                    const float i256 = inv * 256.f; int t_[4];
#pragma unroll
                    for (int q = 0; q < 4; ++q) { t_[q] = 0; t_[q] = __builtin_amdgcn_cvt_pk_fp8_f32(c448(kx[4 * q] * i256), c448(kx[4 * q + 1] * i256), t_[q], false); t_[q] = __builtin_amdgcn_cvt_pk_fp8_f32(c448(kx[4 * q + 2] * i256), c448(kx[4 * q + 3] * i256), t_[q], true); }
                    v4u q8; q8.x = (unsigned)t_[0]; q8.y = (unsigned)t_[1]; q8.z = (unsigned)t_[2]; q8.w = (unsigned)t_[3];
                    *(v4u*)((unsigned char*)KK16 + (size_t)row * 1024 + kc) = q8;
                } else if (p == 2) { *(v4u*)((unsigned char*)V16 + (size_t)row * 1024 + (col - 2048)) = o8; }
                else if (act) {
                    const int off = col - 3072;
                    int buf, k;
                    if (off < 96) { buf = 0; k = off; } else if (off < 192) { buf = 1; k = off - 96; } else if (off < 288) { buf = 2; k = off - 192; } else if (off < 384) { buf = 3; k = off - 288; } else { buf = 4; k = off - 384; }
                    float y[16];
#pragma unroll
                    for (int e = 0; e < 16; ++e) y[e] = (buf < 2) ? tanhf(zs[e]) : ((buf == 4) ? sigm(zs[e]) : zs[e]);
                    v4u t0, t1;
                    t0.x = pk2(y[0], y[1]); t0.y = pk2(y[2], y[3]); t0.z = pk2(y[4], y[5]); t0.w = pk2(y[6], y[7]); t1.x = pk2(y[8], y[9]); t1.y = pk2(y[10], y[11]); t1.z = pk2(y[12], y[13]); t1.w = pk2(y[14], y[15]);
                    bf16* tp = T + (size_t)buf * MROWS * 256 + (size_t)row * 256 + k;
                    *(v4u*)tp = t0; *(v4u*)(tp + 8) = t1;
                }
            }
            for (int i = c.lane; i < 80; i += 64) { const int buf = i / 20, chk = 12 + i % 20;
                *(v4u*)(T + (size_t)buf * MROWS * 256 + (size_t)row * 256 + chk * 8) = (v4u){0u, 0u, 0u, 0u}; }
        }
    }
}

DI void phase_vtranspose(const Args& a, const Ctx& c) {
    const bf16* ZA = (const bf16*)(a.ws + WS_ZA); bf16* VT = (bf16*)(a.ws + WS_VT);
    LAS bf16* tile = (LAS bf16*)(c.lds + c.wave * 9216);
    for (int item = c.gw; item < 256 * 16; item += c.NGW) {
        const int t0 = (item >> 4) * 64, c0 = (item & 15) * 64;
#pragma unroll
        for (int ch = 0; ch < 8; ++ch) *(LAS v4u*)(tile + c.lane * 72 + 8 * ch) = *(const v4u*)(ZA + (size_t)(t0 + c.lane) * 3072 + 2048 + c0 + 8 * ch);
        LDS_WAIT(); asm volatile("" ::: "memory");
        const int cg = c0 + c.lane, b = t0 >> 13, pos0 = t0 & (SEQ - 1);
        bf16* dst = VT + ((size_t)(b * 8 + (cg >> 7)) * 128 + (cg & 127)) * SEQ + pos0;
#pragma unroll
        for (int j = 0; j < 8; ++j) { unsigned e[8];
#pragma unroll
            for (int q = 0; q < 8; ++q) e[q] = tile[(8 * j + q) * 72 + c.lane];
            v4u o; o.x = e[0] | (e[1] << 16); o.y = e[2] | (e[3] << 16); o.z = e[4] | (e[5] << 16); o.w = e[6] | (e[7] << 16);
            *(v4u*)(dst + 8 * j) = o; }
        LDS_WAIT(); asm volatile("" ::: "memory");
    }
}

typedef short bf16x8 __attribute__((ext_vector_type(8)));
struct NaTask { int b, h, i, cq; };
DI void na_part_a(const bf16* ZA, const LAS float* rpbl, int lane, const NaTask t, int half, f32x4 (&S)[8][2], bf16x8 (&pf)[8], float& inv) {
    const int l15 = lane & 15, q4 = lane >> 4, b = t.b, h = t.h, i = t.i, cq = t.cq;
    const int wsc = min(max(16 * cq - 8, 0), 32);
    const int jq = 16 * cq + l15, cs = min(max(jq - 8, 0), 48);
    const int rs = min(max(i - 4, 0), 120);
    const size_t qtok = (size_t)b * SEQ + i * 64 + jq;
    bf16x8 qf[4];
#pragma unroll
    for (int ks = 0; ks < 4; ++ks) qf[ks] = *(const bf16x8*)(ZA + qtok * 3072 + h * 128 + 32 * ks + 8 * q4);
#pragma unroll
    for (int rh = 0; rh < 4; ++rh) {
        if ((rh >> 1) == half) {
        bf16x8 kf[4][4];
#pragma unroll
        for (int tt = 0; tt < 4; ++tt) { const int r = 2 * rh + (tt >> 1), u = tt & 1;
            const int kcol = wsc + 8 * (l15 >> 2) + 4 * u + (l15 & 3);
            const bf16* kp = ZA + ((size_t)b * SEQ + (rs + r) * 64 + kcol) * 3072 + 1024 + h * 128 + 8 * q4;
#pragma unroll
            for (int ks = 0; ks < 4; ++ks) kf[tt][ks] = *(const bf16x8*)(kp + 32 * ks); }
        __builtin_amdgcn_sched_barrier(0);
#pragma unroll
        for (int tt = 0; tt < 4; ++tt) { f32x4 acc = (f32x4){0.f, 0.f, 0.f, 0.f};
#pragma unroll
            for (int ks = 0; ks < 4; ++ks) acc = __builtin_amdgcn_mfma_f32_16x16x32_bf16(kf[tt][ks], qf[ks], acc, 0, 0, 0);
            S[2 * rh + (tt >> 1)][tt & 1] = acc; }
        }
    }
    if (half == 0) return;
    float mx = -1e30f;
#pragma unroll
    for (int r = 0; r < 8; ++r)
#pragma unroll
        for (int u = 0; u < 2; ++u)
#pragma unroll
            for (int j = 0; j < 4; ++j) {
                const int kc = wsc + 8 * q4 + 4 * u + j;
                const bool valid = (kc >= cs) && (kc < cs + 16);
                const int bi = valid ? ((rs + r - i + 7) * 31 + (kc - jq + 15)) : 0;
                const float sv = valid ? (S[r][u][j] + rpbl[bi]) : -1e30f;
                S[r][u][j] = sv; mx = fmaxf(mx, sv);
            }
    mx = fmaxf(mx, __shfl_xor(mx, 16)); mx = fmaxf(mx, __shfl_xor(mx, 32));
    float sum = 0.f;
#pragma unroll
    for (int r = 0; r < 8; ++r)
#pragma unroll
        for (int u = 0; u < 2; ++u)
#pragma unroll
            for (int j = 0; j < 4; ++j) { const float p = __expf(S[r][u][j] - mx); S[r][u][j] = p; sum += p; }
    sum += __shfl_xor(sum, 16); sum += __shfl_xor(sum, 32);
    inv = 1.0f / sum;
#pragma unroll
    for (int r = 0; r < 8; ++r) { v4u w; w.x = pk2(S[r][0][0], S[r][0][1]); w.y = pk2(S[r][0][2], S[r][0][3]); w.z = pk2(S[r][1][0], S[r][1][1]); w.w = pk2(S[r][1][2], S[r][1][3]);
        pf[r] = __builtin_bit_cast(bf16x8, w); }
}
DI void na_part_b(const bf16* VT, bf16* OA, int lane, const NaTask t, int half, const bf16x8 (&pf)[8], float inv) {
    const int l15 = lane & 15, q4 = lane >> 4, b = t.b, h = t.h, i = t.i, cq = t.cq;
    const int wsc = min(max(16 * cq - 8, 0), 32);
    const int rs = min(max(i - 4, 0), 120);
    const size_t qtok = (size_t)b * SEQ + i * 64 + 16 * cq + l15;
#pragma unroll
    for (int dh = 0; dh < 4; ++dh) {
        if ((dh >> 1) == half) {
        bf16x8 vf[2][8];
#pragma unroll
        for (int d4 = 0; d4 < 2; ++d4) { const int dt = 2 * dh + d4;
            const bf16* vp = VT + ((size_t)(b * 8 + h) * 128 + 16 * dt + l15) * SEQ + rs * 64 + wsc + 8 * q4;
#pragma unroll
            for (int r = 0; r < 8; ++r) vf[d4][r] = *(const bf16x8*)(vp + r * 64); }
        __builtin_amdgcn_sched_barrier(0);
#pragma unroll
        for (int d4 = 0; d4 < 2; ++d4) { const int dt = 2 * dh + d4;
            f32x4 o = (f32x4){0.f, 0.f, 0.f, 0.f};
#pragma unroll
            for (int r = 0; r < 8; ++r) o = __builtin_amdgcn_mfma_f32_16x16x32_bf16(vf[d4][r], pf[r], o, 0, 0, 0);
            const float i16 = inv * 16.f; int w = 0; w = __builtin_amdgcn_cvt_pk_fp8_f32(c448(o[0] * i16), c448(o[1] * i16), w, false); w = __builtin_amdgcn_cvt_pk_fp8_f32(c448(o[2] * i16), c448(o[3] * i16), w, true);
            *(int*)((unsigned char*)OA + qtok * 1024 + h * 128 + 16 * dt + 4 * q4) = w; }
        }
    }
}

DI void phase_na_attention(const Args& a, const Ctx& c) {
    const bf16* ZA = (const bf16*)(a.ws + WS_ZA); const bf16* VT = (const bf16*)(a.ws + WS_VT); bf16* OA = (bf16*)(a.ws + WS_OA);
    LAS float* rpbl = (LAS float*)c.lds;
    for (int blk = c.bid; blk < 256; blk += c.G) {
        const int b = blk >> 7, h = (blk >> 4) & 7, i0 = ((blk & 15) * 2 + 1) * 4;
        __syncthreads();
        for (int t = c.tid; t < 465; t += 512) rpbl[t] = a.in[10][h * 465 + t];
        __syncthreads();
        const int l15 = c.lane & 15, q4 = c.lane >> 4, cq = c.wave & 3;
        const int wsc = min(max(16 * cq - 8, 0), 32);
        const int jq = 16 * cq + l15, cs = min(max(jq - 8, 0), 48);
#pragma unroll 1
        for (int k = 0; k < 2; ++k) {
            const int i = i0 + 2 * k + (c.wave >> 2);
            const int rs = min(max(i - 4, 0), 120);
            const size_t qtok = (size_t)b * SEQ + i * 64 + jq;
            bf16x8 qf[4];
#pragma unroll
            for (int ks = 0; ks < 4; ++ks) qf[ks] = *(const bf16x8*)(ZA + qtok * 3072 + h * 128 + 32 * ks + 8 * q4);
            f32x4 S[8][2];
#pragma unroll
            for (int rh = 0; rh < 2; ++rh) {
                bf16x8 kf[8][4];
#pragma unroll
                for (int t = 0; t < 8; ++t) { const int r = 4 * rh + (t >> 1), u = t & 1;
                    const int kcol = wsc + 8 * (l15 >> 2) + 4 * u + (l15 & 3);
                    const bf16* kp = ZA + ((size_t)b * SEQ + (rs + r) * 64 + kcol) * 3072 + 1024 + h * 128 + 8 * q4;
#pragma unroll
                    for (int ks = 0; ks < 4; ++ks) kf[t][ks] = *(const bf16x8*)(kp + 32 * ks); }
                __builtin_amdgcn_sched_barrier(0);
#pragma unroll
                for (int t = 0; t < 8; ++t) { f32x4 acc = (f32x4){0.f, 0.f, 0.f, 0.f};
#pragma unroll
                    for (int ks = 0; ks < 4; ++ks) acc = __builtin_amdgcn_mfma_f32_16x16x32_bf16(kf[t][ks], qf[ks], acc, 0, 0, 0);
                    S[4 * rh + (t >> 1)][t & 1] = acc; }
            }
            float mx = -1e30f;
#pragma unroll
            for (int r = 0; r < 8; ++r)
#pragma unroll
                for (int u = 0; u < 2; ++u)
#pragma unroll
                    for (int j = 0; j < 4; ++j) {
                        const int kc = wsc + 8 * q4 + 4 * u + j;
                        const bool valid = (kc >= cs) && (kc < cs + 16);
                        const int bi = valid ? ((rs + r - i + 7) * 31 + (kc - jq + 15)) : 0;
                        const float sv = valid ? (S[r][u][j] + rpbl[bi]) : -1e30f;
                        S[r][u][j] = sv; mx = fmaxf(mx, sv);
                    }
            mx = fmaxf(mx, __shfl_xor(mx, 16)); mx = fmaxf(mx, __shfl_xor(mx, 32));
            float sum = 0.f;
#pragma unroll
            for (int r = 0; r < 8; ++r)
#pragma unroll
                for (int u = 0; u < 2; ++u)
#pragma unroll
                    for (int j = 0; j < 4; ++j) { const float p = __expf(S[r][u][j] - mx); S[r][u][j] = p; sum += p; }
            sum += __shfl_xor(sum, 16); sum += __shfl_xor(sum, 32);
            const float inv = 1.0f / sum;
            bf16x8 pf[8];
#pragma unroll
            for (int r = 0; r < 8; ++r) { v4u w; w.x = pk2(S[r][0][0], S[r][0][1]); w.y = pk2(S[r][0][2], S[r][0][3]); w.z = pk2(S[r][1][0], S[r][1][1]); w.w = pk2(S[r][1][2], S[r][1][3]);
                pf[r] = __builtin_bit_cast(bf16x8, w); }
#pragma unroll
            for (int dh = 0; dh < 2; ++dh) {
                bf16x8 vf[4][8];
#pragma unroll
                for (int d4 = 0; d4 < 4; ++d4) { const int dt = 4 * dh + d4;
                    const bf16* vp = VT + ((size_t)(b * 8 + h) * 128 + 16 * dt + l15) * SEQ + rs * 64 + wsc + 8 * q4;
#pragma unroll
                    for (int r = 0; r < 8; ++r) vf[d4][r] = *(const bf16x8*)(vp + r * 64); }
                __builtin_amdgcn_sched_barrier(0);
#pragma unroll
                for (int d4 = 0; d4 < 4; ++d4) { const int dt = 4 * dh + d4;
                    f32x4 o = (f32x4){0.f, 0.f, 0.f, 0.f};
#pragma unroll
                    for (int r = 0; r < 8; ++r) o = __builtin_amdgcn_mfma_f32_16x16x32_bf16(vf[d4][r], pf[r], o, 0, 0, 0);
                    const float i16 = inv * 16.f; int w = 0; w = __builtin_amdgcn_cvt_pk_fp8_f32(c448(o[0] * i16), c448(o[1] * i16), w, false); w = __builtin_amdgcn_cvt_pk_fp8_f32(c448(o[2] * i16), c448(o[3] * i16), w, true);
                    *(int*)((unsigned char*)OA + qtok * 1024 + h * 128 + 16 * dt + 4 * q4) = w; }
            }
        }
    }
}

typedef short bf16x4 __attribute__((ext_vector_type(4)));
typedef __bf16 bf16x2_t __attribute__((ext_vector_type(2)));
DI unsigned cvtpk(float lo, float hi) { f32x2 v = {lo, hi}; bf16x2_t b = __builtin_convertvector(v, bf16x2_t); return __builtin_bit_cast(unsigned, b); }
DI f32x4 mfma32(bf16x8 a, bf16x8 b, f32x4 c) { return __builtin_amdgcn_mfma_f32_16x16x32_bf16(a, b, c, 0, 0, 0); }
DI f32x4 mfma16(bf16x4 a, bf16x4 b, f32x4 c) { return __builtin_amdgcn_mfma_f32_16x16x16bf16_1k(a, b, c, 0, 0, 0); }
DI bf16x4 pack4(f32x4 v) { v2u w; w.x = cvtpk(v[0], v[1]); w.y = cvtpk(v[2], v[3]); return __builtin_bit_cast(bf16x4, w); }
DI bf16x8 pack8(f32x4 a, f32x4 b) { v4u w; w.x = cvtpk(a[0], a[1]); w.y = cvtpk(a[2], a[3]); w.z = cvtpk(b[0], b[1]); w.w = cvtpk(b[2], b[3]); return __builtin_bit_cast(bf16x8, w); }
#define SC_BARRIER() do { asm volatile("s_waitcnt lgkmcnt(0)" ::: "memory"); __builtin_amdgcn_s_barrier(); asm volatile("" ::: "memory"); } while (0)
constexpr int SC_SLOT = 16384, SC_SCR = 131072, SC_SCRB = 6528, SC_ROW = 136;
DI void phase_scan(const Args& a, const Ctx& c) {
    unsigned char* ws = a.ws;
    const bf16* R16 = (const bf16*)(ws + WS_R); const bf16* K16 = (const bf16*)(ws + WS_K); const bf16* V16 = (const bf16*)(ws + WS_V); const bf16* KK16 = (const bf16*)(ws + WS_KK);
    const int lane = c.lane, l15 = lane & 15, kq = lane >> 4;
    const f32x4 Z4 = (f32x4){0.f, 0.f, 0.f, 0.f};
    for (int job = c.bid; job < 256; job += c.G) {
        const int p = job >> 2, sg = job & 3, cb = 128 * sg, dir = p >> 5, b = (p >> 4) & 1, h = p & 15;
        bf16* PHI = (bf16*)(ws + (dir ? WS_PHIB : WS_PHIF));
        LAS float* rpbl = (LAS float*)(c.lds + 157824);
        for (int t_ = c.tid; t_ < 465; t_ += 512) rpbl[t_] = a.in[10][(((job * 32) >> 9) & 7) * 465 + t_];
        const bf16* IC = (const bf16*)(ws + (dir ? WS_ICB : WS_ICF)); const bf16* LW = (const bf16*)(ws + (dir ? WS_LWB : WS_LWF));
        bf16* O = (bf16*)(ws + (dir ? WS_OBW : WS_OF));
        __syncthreads();
        if (c.wave >= 4) {
            const int pw = c.wave - 4;
            LAS unsigned char* scr = c.lds + SC_SCR + pw * SC_SCRB;
            float ka[2][8];
#pragma unroll
            for (int ks = 0; ks < 2; ++ks)
#pragma unroll
                for (int e = 0; e < 8; ++e) ka[ks][e] = a.in[18][h * 64 + 32 * ks + 16 * (e >> 2) + 4 * kq + (e & 3)];
#pragma unroll
            for (int ks = 0; ks < 2; ++ks)
#pragma unroll
                for (int e = 0; e < 8; ++e) asm volatile("" : "+v"(ka[ks][e]));
            v2u raw[6][4], rawN[6][4];
#define SC_LOAD(dst, cc) do { const int ng_ = 16 * (cb + (cc)) + l15, t_ = dir ? (SEQ - 1 - ng_) : ng_; const size_t o_ = (size_t)(b * SEQ + t_) * 1024 + h * 64 + 4 * kq; \
                _Pragma("unroll") for (int g_ = 0; g_ < 4; ++g_) { dst[0][g_].x = *(const unsigned*)((const unsigned char*)R16 + o_ + 16 * g_); dst[1][g_].x = *(const unsigned*)((const unsigned char*)K16 + o_ + 16 * g_); \
                    dst[2][g_].x = *(const unsigned*)((const unsigned char*)V16 + o_ + 16 * g_); dst[3][g_].x = *(const unsigned*)((const unsigned char*)KK16 + o_ + 16 * g_); \
                    dst[0][g_].y = 0u; dst[1][g_].y = 0u; dst[2][g_].y = 0u; dst[3][g_].y = 0u; \
                    dst[4][g_] = *(const v2u*)(IC + o_ + 16 * g_); dst[5][g_] = *(const v2u*)(LW + o_ + 16 * g_); } } while (0)
#define SC_FLUSH(sl, ch) do { const int n_ = lane >> 2, pt_ = lane & 3, ng_ = 16 * (cb + (ch)) + n_, t_ = dir ? (SEQ - 1 - ng_) : ng_; \
                const LAS v4u* s_ = (const LAS v4u*)((sl) + 9984 + pt_ * 1536 + 512 + n_ * 32); const v4u x0_ = s_[0], x1_ = s_[1], y0_ = s_[32], y1_ = s_[33]; \
                const size_t go_ = (size_t)(b * SEQ + t_) * 1024 + h * 64 + 16 * pt_; \
                v4u* d_ = (v4u*)(O + go_); d_[0] = x0_; d_[1] = x1_; \
                if (sg > 0) { v4u* e_ = (v4u*)(PHI + (size_t)(b * 6144 + ng_ - 2048) * 1024 + h * 64 + 16 * pt_); e_[0] = y0_; e_[1] = y1_; } } while (0)
            SC_LOAD(raw, pw); SC_LOAD(rawN, pw + 4);
#pragma unroll 1
            for (int it = -1; it < 34; ++it) {
                const int cc = 4 * (it + 1) + pw;
                if (cc >= 128 && cc < 136) { SC_FLUSH(c.lds + (((it + 1) & 1) * 4 + pw) * SC_SLOT, cc - 8); }
                if (cc < 128) {
                    LAS unsigned char* slot = c.lds + (((it + 1) & 1) * 4 + pw) * SC_SLOT;
                    if (cc >= 8) SC_FLUSH(slot, cc - 8);
                    f32x4 mab_b = Z4, mab_a = Z4, mak_a = Z4, mrb_a = Z4, mrk_a = Z4;
#pragma unroll
                    for (int ks = 0; ks < 2; ++ks) {
                        float r[8], k[8], v[8], kk[8], ic[8], lw[8];
#pragma unroll
                        for (int hf = 0; hf < 2; ++hf) { const int g = 2 * ks + hf;
                            { const f32x2 a0 = __builtin_amdgcn_cvt_pk_f32_fp8((int)raw[0][g].x, false) * 0.0625f, a1 = __builtin_amdgcn_cvt_pk_f32_fp8((int)raw[0][g].x, true) * 0.0625f;
                              r[4 * hf] = a0.x; r[4 * hf + 1] = a0.y; r[4 * hf + 2] = a1.x; r[4 * hf + 3] = a1.y; }
                            { const f32x2 a0 = __builtin_amdgcn_cvt_pk_f32_fp8((int)raw[1][g].x, false) * 0.0625f, a1 = __builtin_amdgcn_cvt_pk_f32_fp8((int)raw[1][g].x, true) * 0.0625f;
                              k[4 * hf] = a0.x; k[4 * hf + 1] = a0.y; k[4 * hf + 2] = a1.x; k[4 * hf + 3] = a1.y; }
                            { const f32x2 a0 = __builtin_amdgcn_cvt_pk_f32_fp8((int)raw[2][g].x, false) * 0.0625f, a1 = __builtin_amdgcn_cvt_pk_f32_fp8((int)raw[2][g].x, true) * 0.0625f;
                              v[4 * hf] = a0.x; v[4 * hf + 1] = a0.y; v[4 * hf + 2] = a1.x; v[4 * hf + 3] = a1.y; }
                            { const f32x2 a0 = __builtin_amdgcn_cvt_pk_f32_fp8((int)raw[3][g].x, false) * 0.00390625f, a1 = __builtin_amdgcn_cvt_pk_f32_fp8((int)raw[3][g].x, true) * 0.00390625f;
                              kk[4 * hf] = a0.x; kk[4 * hf + 1] = a0.y; kk[4 * hf + 2] = a1.x; kk[4 * hf + 3] = a1.y; }
                            ic[4 * hf] = bflo(raw[4][g].x); ic[4 * hf + 1] = bfhi(raw[4][g].x); ic[4 * hf + 2] = bflo(raw[4][g].y); ic[4 * hf + 3] = bfhi(raw[4][g].y);
                            lw[4 * hf] = bflo(raw[5][g].x); lw[4 * hf + 1] = bfhi(raw[5][g].x); lw[4 * hf + 2] = bflo(raw[5][g].y); lw[4 * hf + 3] = bfhi(raw[5][g].y); }
                        float cum[8], tot[8];
#pragma unroll
                        for (int e = 0; e < 8; ++e) cum[e] = lw[e];
#pragma unroll
                        for (int e = 0; e < 8; ++e) { tot[e] = row16_sum(lw[e]);
                            cum[e] += dpp_mov<0x111>(cum[e]); cum[e] += dpp_mov<0x112>(cum[e]); cum[e] += dpp_mov<0x114>(cum[e]); cum[e] += dpp_mov<0x118>(cum[e]); }
                        float at[8], bh[8], kh[8], rt[8], bbv[8], kbv[8], gam[8];
#pragma unroll
                        for (int e = 0; e < 8; ++e) gam[e] = __expf(tot[e]);
#pragma unroll
                        for (int e = 0; e < 8; ++e) {
                            const float bb = kk[e] * ic[e], kd = k[e] * (1.0f + (ic[e] - 1.0f) * ka[ks][e]);
                            const float ep = __expf(cum[e]), en = __builtin_amdgcn_rcpf(ep), ex = ep * __expf(-lw[e]), et = gam[e] * en;
                            at[e] = -kk[e] * ex; bh[e] = bb * en; kh[e] = kd * en; rt[e] = r[e] * ep; bbv[e] = bb * et; kbv[e] = kd * et;
                        }
                        v4u w;
                        w.x = cvtpk(at[0], at[1]); w.y = cvtpk(at[2], at[3]); w.z = cvtpk(at[4], at[5]); w.w = cvtpk(at[6], at[7]); const bf16x8 at_f = __builtin_bit_cast(bf16x8, w);
                        w.x = cvtpk(bh[0], bh[1]); w.y = cvtpk(bh[2], bh[3]); w.z = cvtpk(bh[4], bh[5]); w.w = cvtpk(bh[6], bh[7]); const bf16x8 bh_f = __builtin_bit_cast(bf16x8, w);
                        w.x = cvtpk(kh[0], kh[1]); w.y = cvtpk(kh[2], kh[3]); w.z = cvtpk(kh[4], kh[5]); w.w = cvtpk(kh[6], kh[7]); const bf16x8 kh_f = __builtin_bit_cast(bf16x8, w);
                        w.x = cvtpk(rt[0], rt[1]); w.y = cvtpk(rt[2], rt[3]); w.z = cvtpk(rt[4], rt[5]); w.w = cvtpk(rt[6], rt[7]); const bf16x8 rt_f = __builtin_bit_cast(bf16x8, w);
                        *(LAS bf16x8*)(slot + ks * 1024 + lane * 16) = at_f;
                        *(LAS bf16x8*)(slot + 2048 + ks * 1024 + lane * 16) = rt_f;
                        mab_b = mfma32(at_f, bh_f, mab_b); mab_a = mfma32(bh_f, at_f, mab_a); mak_a = mfma32(kh_f, at_f, mak_a); mrb_a = mfma32(bh_f, rt_f, mrb_a); mrk_a = mfma32(kh_f, rt_f, mrk_a);
#pragma unroll
                        for (int hf = 0; hf < 2; ++hf) { const int chb = (32 * ks + 16 * hf + 4 * kq) * 2;
                            v2u q; q.x = cvtpk(bbv[4 * hf], bbv[4 * hf + 1]); q.y = cvtpk(bbv[4 * hf + 2], bbv[4 * hf + 3]); *(LAS v2u*)(scr + l15 * SC_ROW + chb) = q;
                            q.x = cvtpk(kbv[4 * hf], kbv[4 * hf + 1]); q.y = cvtpk(kbv[4 * hf + 2], kbv[4 * hf + 3]); *(LAS v2u*)(scr + 2176 + l15 * SC_ROW + chb) = q;
                            q.x = cvtpk(v[4 * hf], v[4 * hf + 1]); q.y = cvtpk(v[4 * hf + 2], v[4 * hf + 3]); *(LAS v2u*)(scr + 4352 + l15 * SC_ROW + chb) = q; }
                        if (l15 == 0) {
#pragma unroll
                            for (int e = 0; e < 8; ++e) *(LAS float*)(slot + 9728 + 4 * (32 * ks + 16 * (e >> 2) + 4 * kq + (e & 3))) = gam[e]; }
                    }
                    f32x4 idm;
#pragma unroll
                    for (int rg = 0; rg < 4; ++rg) { const int m = 4 * kq + rg;
                        if (!(m < l15)) { mab_a[rg] = 0.f; mak_a[rg] = 0.f; }
                        if (!(m <= l15)) { mrb_a[rg] = 0.f; mrk_a[rg] = 0.f; }
                        if (!(l15 < m)) mab_b[rg] = 0.f;
                        idm[rg] = (m == l15) ? 1.0f : 0.0f; }
                    const bf16x4 Ma = pack4(mab_a), Mb = pack4(mab_b);
                    const f32x4 m2b = mfma16(Ma, Mb, Z4), m2a = mfma16(Mb, Ma, Z4);
                    const bf16x4 M2a = pack4(m2a), M2b = pack4(m2b);
                    const f32x4 m4b = mfma16(M2a, M2b, Z4), m4a = mfma16(M2b, M2a, Z4);
                    const bf16x4 M4a = pack4(m4a), M4b = pack4(m4b);
                    const f32x4 m8b = mfma16(M4a, M4b, Z4);
                    const f32x4 q1a = mfma16(pack4(m2b + idm), pack4(mab_a + idm), Z4);
                    const f32x4 q2a = mfma16(pack4(m4b + idm), pack4(q1a), Z4);
                    const f32x4 ta = mfma16(pack4(m8b + idm), pack4(q2a), Z4);
                    *(LAS bf16x4*)(slot + 8192 + lane * 8) = pack4(ta);
                    *(LAS bf16x4*)(slot + 8704 + lane * 8) = pack4(mrb_a);
                    *(LAS bf16x4*)(slot + 9216 + lane * 8) = pack4(mrk_a);
                    const bf16x4 Mak = pack4(mak_a);
                    LDS_WAIT(); asm volatile("" ::: "memory");
#pragma unroll
                    for (int jt = 0; jt < 4; ++jt) {
                        unsigned e0[4], e1[4], e2[4];
#pragma unroll
                        for (int e = 0; e < 4; ++e) { const int o = (4 * kq + e) * SC_ROW + (16 * jt + l15) * 2;
                            e0[e] = *(const LAS unsigned short*)(scr + o); e1[e] = *(const LAS unsigned short*)(scr + 2176 + o); e2[e] = *(const LAS unsigned short*)(scr + 4352 + o); }
                        v4u bk; bk.x = e0[0] | (e0[1] << 16); bk.y = e0[2] | (e0[3] << 16); bk.z = e1[0] | (e1[1] << 16); bk.w = e1[2] | (e1[3] << 16);
                        *(LAS v4u*)(slot + 4096 + jt * 1024 + lane * 16) = bk;
                        v2u vf; vf.x = e2[0] | (e2[1] << 16); vf.y = e2[2] | (e2[3] << 16);
                        *(LAS v2u*)(slot + 9984 + jt * 1536 + lane * 8) = vf;
                        const f32x4 w2 = mfma16(Mak, __builtin_bit_cast(bf16x4, vf), Z4);
                        *(LAS f32x4*)(slot + 9984 + jt * 1536 + 512 + lane * 16) = w2;
                    }
                    LDS_WAIT(); asm volatile("" ::: "memory");
                }
#pragma unroll
                for (int i = 0; i < 6; ++i)
#pragma unroll
                    for (int g = 0; g < 4; ++g) raw[i][g] = rawN[i][g];
                if (cc + 8 < 128) SC_LOAD(rawN, cc + 8);
                SC_BARRIER();
            }
#undef SC_LOAD
#undef SC_FLUSH
        } else {
            if (c.wave >= 2) {
                const bf16* ZA = (const bf16*)(ws + WS_ZA); const bf16* VT = (const bf16*)(ws + WS_VT); bf16* OA = (bf16*)(ws + WS_OA);
                bf16x8 pf[8]; float inv = 0.f; f32x4 Sa[8][2];
#pragma unroll
                for (int r = 0; r < 8; ++r) { pf[r] = (bf16x8){0, 0, 0, 0, 0, 0, 0, 0}; Sa[r][0] = Z4; Sa[r][1] = Z4; }
#pragma unroll 1
                for (int it = -1; it < 34; ++it) {
                    const int pi = it + 1;
                    if (pi < 32) { const int id = job * 32 + 2 * (pi >> 2) + (c.wave - 2);
                        NaTask t; t.cq = id & 3; t.i = (id >> 2) & 127; t.h = (id >> 9) & 7; t.b = id >> 12;
                        const int part = pi & 3;
                        if (part == 0) na_part_a(ZA, rpbl, lane, t, 0, Sa, pf, inv); else if (part == 1) na_part_a(ZA, rpbl, lane, t, 1, Sa, pf, inv);
                        else if (part == 2) na_part_b(VT, OA, lane, t, 0, pf, inv); else na_part_b(VT, OA, lane, t, 1, pf, inv); }
                    SC_BARRIER();
                }
            } else {
            f32x4 S[2][4], P[2][4];
#pragma unroll
            for (int vv = 0; vv < 2; ++vv)
#pragma unroll
                for (int jt = 0; jt < 4; ++jt) { S[vv][jt] = Z4;
#pragma unroll
                    for (int rg = 0; rg < 4; ++rg) P[vv][jt][rg] = (16 * jt + 4 * kq + rg == 16 * (2 * c.wave + vv) + l15) ? 1.0f : 0.0f; }
#pragma unroll 1
            for (int it = -1; it < 34; ++it) {
                if (it >= 0 && it < 32) {
#pragma unroll 1
                    for (int q = 0; q < 4; ++q) {
                        LAS unsigned char* slot = c.lds + ((it & 1) * 4 + q) * SC_SLOT;
                        const bf16x8 at0 = *(const LAS bf16x8*)(slot + lane * 16), at1 = *(const LAS bf16x8*)(slot + 1024 + lane * 16);
                        const bf16x8 rt0 = *(const LAS bf16x8*)(slot + 2048 + lane * 16), rt1 = *(const LAS bf16x8*)(slot + 3072 + lane * 16);
                        const bf16x4 Ta = *(const LAS bf16x4*)(slot + 8192 + lane * 8), Mrb = *(const LAS bf16x4*)(slot + 8704 + lane * 8), Mrk = *(const LAS bf16x4*)(slot + 9216 + lane * 8);
                        bf16x8 bkf[4]; f32x4 gam[4];
#pragma unroll
                        for (int jt = 0; jt < 4; ++jt) { gam[jt] = *(const LAS f32x4*)(slot + 9728 + (16 * jt + 4 * kq) * 4); bkf[jt] = *(const LAS bf16x8*)(slot + 4096 + jt * 1024 + lane * 16); }
#pragma unroll
                        for (int vv = 0; vv < 2; ++vv) {
                            const int vt = 2 * c.wave + vv;
                            const bf16x4 Vf = *(const LAS bf16x4*)(slot + 9984 + vt * 1536 + lane * 8);
                            const f32x4 W2 = *(const LAS f32x4*)(slot + 9984 + vt * 1536 + 512 + lane * 16);
                            const bf16x8 sp0 = pack8(S[vv][0], S[vv][1]), sp1 = pack8(S[vv][2], S[vv][3]);
                            f32x4 X = mfma32(at0, sp0, W2); X = mfma32(at1, sp1, X);
                            f32x4 Oc = mfma32(rt0, sp0, Z4); Oc = mfma32(rt1, sp1, Oc);
                            const f32x4 U = mfma16(Ta, pack4(X), Z4);
                            const bf16x4 Up = pack4(U);
                            Oc = mfma16(Mrb, Up, Oc); Oc = mfma16(Mrk, Vf, Oc);
                            const v2u upw = __builtin_bit_cast(v2u, Up), vfw = __builtin_bit_cast(v2u, Vf);
                            const bf16x8 UV = __builtin_bit_cast(bf16x8, ((v4u){upw.x, upw.y, vfw.x, vfw.y}));
                            const bf16x8 pp0 = pack8(P[vv][0], P[vv][1]), pp1 = pack8(P[vv][2], P[vv][3]);
                            f32x4 Xp = mfma32(at0, pp0, Z4); Xp = mfma32(at1, pp1, Xp);
                            f32x4 Op = mfma32(rt0, pp0, Z4); Op = mfma32(rt1, pp1, Op);
                            const bf16x4 Upp = pack4(mfma16(Ta, pack4(Xp), Z4));
                            Op = mfma16(Mrb, Upp, Op);
                            const v2u uppw = __builtin_bit_cast(v2u, Upp);
                            const bf16x8 UVp = __builtin_bit_cast(bf16x8, ((v4u){uppw.x, uppw.y, 0u, 0u}));
#pragma unroll
                            for (int jt = 0; jt < 4; ++jt) { S[vv][jt] = mfma32(bkf[jt], UV, S[vv][jt] * gam[jt]); P[vv][jt] = mfma32(bkf[jt], UVp, P[vv][jt] * gam[jt]); }
                            LAS bf16* ost = (LAS bf16*)(slot + 9984 + vt * 1536 + 512);
#pragma unroll
                            for (int rg = 0; rg < 4; ++rg) { ost[(4 * kq + rg) * 16 + l15] = (bf16)(cvtpk(Oc[rg], 0.f) & 0xffffu); ost[256 + (4 * kq + rg) * 16 + l15] = (bf16)(cvtpk(Op[rg], 0.f) & 0xffffu); }
                        }
                    }
                }
                SC_BARRIER();
            }
            float* QS = (float*)(ws + WS_QS) + (size_t)job * 4096; float* PS = (float*)(ws + WS_PS) + (size_t)job * 4096;
#pragma unroll
            for (int vv = 0; vv < 2; ++vv)
#pragma unroll
                for (int jt = 0; jt < 4; ++jt) { const int vt = 2 * c.wave + vv;
                    *(f32x4*)(QS + (16 * vt + l15) * 64 + 16 * jt + 4 * kq) = S[vv][jt]; *(f32x4*)(PS + (16 * vt + l15) * 64 + 16 * jt + 4 * kq) = P[vv][jt]; }
            }
        }
    }
}
DI void phase_scan_chain(const Args& a, const Ctx& c) {
    unsigned char* ws = a.ws;
    LAS float* Sc = (LAS float*)c.lds;
    LAS float* Pm = (LAS float*)(c.lds + 16640);
    const int v = c.tid >> 3, jg = c.tid & 7;
    for (int p = c.bid; p < 64; p += c.G) {
        const float* QS = (const float*)(ws + WS_QS) + (size_t)p * 4 * 4096; const float* PS = (const float*)(ws + WS_PS) + (size_t)p * 4 * 4096;
        bf16* SST = (bf16*)(ws + WS_SST) + (size_t)p * 4 * 4096;
        float acc[8];
#pragma unroll
        for (int e = 0; e < 8; ++e) acc[e] = QS[v * 64 + 8 * jg + e];
#pragma unroll 1
        for (int seg = 1; seg < 4; ++seg) {
            __syncthreads();
#pragma unroll
            for (int e = 0; e < 8; ++e) Sc[v * 65 + 8 * jg + e] = acc[e];
            { v4u o; o.x = pk2(acc[0], acc[1]); o.y = pk2(acc[2], acc[3]); o.z = pk2(acc[4], acc[5]); o.w = pk2(acc[6], acc[7]); *(v4u*)(SST + seg * 4096 + v * 64 + 8 * jg) = o; }
            if (seg == 3) break;
            for (int i = 0; i < 8; ++i) Pm[c.tid + 512 * i] = PS[seg * 4096 + c.tid + 512 * i];
            __syncthreads();
#pragma unroll
            for (int e = 0; e < 8; ++e) acc[e] = QS[seg * 4096 + v * 64 + 8 * jg + e];
            for (int i = 0; i < 64; ++i) { const float sv = Sc[v * 65 + i];
#pragma unroll
                for (int e = 0; e < 8; ++e) acc[e] += sv * Pm[i * 64 + 8 * jg + e]; }
        }
        __syncthreads();
    }
}
DI void phase_scan_fix(const Args& a, const Ctx& c) {
    unsigned char* ws = a.ws;
    const int lane = c.lane, l15 = lane & 15, kq = lane >> 4;
    const f32x4 Z4 = (f32x4){0.f, 0.f, 0.f, 0.f};
    for (int item = c.gw; item < 64 * 3 * 128; item += c.NGW) {
        const int tile = item & 127, ps = item >> 7, seg = 1 + ps % 3, p = ps / 3, dir = p >> 5, b = (p >> 4) & 1, h = p & 15;
        const bf16* PHI = (const bf16*)(ws + (dir ? WS_PHIB : WS_PHIF)); bf16* O = (bf16*)(ws + (dir ? WS_OBW : WS_OF));
        const bf16* SST = (const bf16*)(ws + WS_SST) + (size_t)(p * 4 + seg) * 4096;
        const int ng0 = 16 * (128 * seg + tile);
        const size_t pa = (size_t)(b * 6144 + ng0 + l15 - 2048) * 1024 + h * 64;
        const bf16x8 a0 = *(const bf16x8*)(PHI + pa + 8 * kq), a1 = *(const bf16x8*)(PHI + pa + 32 + 8 * kq);
#pragma unroll
        for (int vt = 0; vt < 4; ++vt) {
            const bf16x8 b0 = *(const bf16x8*)(SST + (16 * vt + l15) * 64 + 8 * kq), b1 = *(const bf16x8*)(SST + (16 * vt + l15) * 64 + 32 + 8 * kq);
            f32x4 cc = mfma32(a0, b0, Z4); cc = mfma32(a1, b1, cc);
#pragma unroll
            for (int rg = 0; rg < 4; ++rg) { const int ng = ng0 + 4 * kq + rg, t = dir ? (SEQ - 1 - ng) : ng;
                bf16* op = O + (size_t)(b * SEQ + t) * 1024 + h * 64 + 16 * vt + l15;
                *op = (bf16)(cvtpk(bflo((unsigned)*op) + cc[rg], 0.f) & 0xffffu); }
        }
    }
}

DI void phase_rwkv_post(const Args& a, const Ctx& c) {
    unsigned char* ws = a.ws;
    const bf16* OF = (const bf16*)(ws + WS_OF); const bf16* OB = (const bf16*)(ws + WS_OBW);
    const bf16* R16 = (const bf16*)(ws + WS_R); const bf16* K16 = (const bf16*)(ws + WS_K); const bf16* V16 = (const bf16*)(ws + WS_V); const bf16* G16 = (const bf16*)(ws + WS_G);
    bf16* OUT = (bf16*)(ws + WS_OB16);
    const int c0 = c.lane * 16;
    float rk[16], lnw[16], lnb[16];
#pragma unroll
    for (int e = 0; e < 16; ++e) { rk[e] = a.in[19][c0 + e]; lnw[e] = a.in[20][c0 + e]; lnb[e] = a.in[21][c0 + e]; }
    for (int row = c.gw; row < MROWS; row += c.NGW) {
        const size_t off = (size_t)row * 1024 + c0;
        float o[16], r[16], k[16], v[16], g[16];
#pragma unroll
        for (int hh = 0; hh < 2; ++hh) {
            const v4u uf = *(const v4u*)(OF + off + 8 * hh), ub = *(const v4u*)(OB + off + 8 * hh), ug = *(const v4u*)(G16 + off + 8 * hh);
            const unsigned f4[4] = {uf.x, uf.y, uf.z, uf.w}, b4[4] = {ub.x, ub.y, ub.z, ub.w}, g4[4] = {ug.x, ug.y, ug.z, ug.w};
#pragma unroll
            for (int e = 0; e < 4; ++e) { const int i0 = 8 * hh + 2 * e;
                o[i0] = bflo(f4[e]) + bflo(b4[e]); o[i0 + 1] = bfhi(f4[e]) + bfhi(b4[e]);
                g[i0] = bflo(g4[e]); g[i0 + 1] = bfhi(g4[e]); }
        }
        {
            const v4u ur = *(const v4u*)((const unsigned char*)R16 + off), uk = *(const v4u*)((const unsigned char*)K16 + off), uv = *(const v4u*)((const unsigned char*)V16 + off);
            const unsigned r4[4] = {ur.x, ur.y, ur.z, ur.w}, k4[4] = {uk.x, uk.y, uk.z, uk.w}, v4[4] = {uv.x, uv.y, uv.z, uv.w};
#pragma unroll
            for (int q = 0; q < 4; ++q) {
                const f32x2 r0 = __builtin_amdgcn_cvt_pk_f32_fp8((int)r4[q], false), r1 = __builtin_amdgcn_cvt_pk_f32_fp8((int)r4[q], true);
                const f32x2 k0 = __builtin_amdgcn_cvt_pk_f32_fp8((int)k4[q], false), k1 = __builtin_amdgcn_cvt_pk_f32_fp8((int)k4[q], true);
                const f32x2 v0 = __builtin_amdgcn_cvt_pk_f32_fp8((int)v4[q], false), v1 = __builtin_amdgcn_cvt_pk_f32_fp8((int)v4[q], true);
                r[4 * q] = r0.x; r[4 * q + 1] = r0.y; r[4 * q + 2] = r1.x; r[4 * q + 3] = r1.y; k[4 * q] = k0.x; k[4 * q + 1] = k0.y; k[4 * q + 2] = k1.x; k[4 * q + 3] = k1.y;
                v[4 * q] = v0.x; v[4 * q + 1] = v0.y; v[4 * q + 2] = v1.x; v[4 * q + 3] = v1.y; }
        }
        float s = 0.f, bs = 0.f;
#pragma unroll
        for (int e = 0; e < 16; ++e) { s += o[e]; bs += r[e] * k[e] * rk[e]; }
        s += __shfl_xor(s, 1); s += __shfl_xor(s, 2); bs += __shfl_xor(bs, 1); bs += __shfl_xor(bs, 2);
        bs *= (1.0f / 4096.0f);
        const float mean = s * (1.0f / 64.0f);
        float q = 0.f;
#pragma unroll
        for (int e = 0; e < 16; ++e) { o[e] -= mean; q += o[e] * o[e]; }
        q += __shfl_xor(q, 1); q += __shfl_xor(q, 2);
        const float rstd = rsqrtf(q * (1.0f / 64.0f) + 64e-5f);
        float y[16];
#pragma unroll
        for (int e = 0; e < 16; ++e) y[e] = (o[e] * rstd * lnw[e] + lnb[e] + bs * v[e]) * g[e];
        int t[4];
#pragma unroll
        for (int q = 0; q < 4; ++q) { t[q] = 0; t[q] = __builtin_amdgcn_cvt_pk_fp8_f32(c448(y[4 * q] * 16.f), c448(y[4 * q + 1] * 16.f), t[q], false); t[q] = __builtin_amdgcn_cvt_pk_fp8_f32(c448(y[4 * q + 2] * 16.f), c448(y[4 * q + 3] * 16.f), t[q], true); }
        v4u w0; w0.x = (unsigned)t[0]; w0.y = (unsigned)t[1]; w0.z = (unsigned)t[2]; w0.w = (unsigned)t[3];
        *(v4u*)((unsigned char*)OUT + off) = w0;
    }
}

DI void tables_load(const Args& a, int lane, int rp, f32x4 (&v)[2][8]) {
    if (rp >= 16384) return;
#pragma unroll
    for (int z = 0; z < 2; ++z) { const int rowi = 2 * rp + z, tb = rowi >> 14, row = rowi & 16383;
        const float* src = a.in[28 + tb] + (size_t)row * 2048 + lane * 4;
#pragma unroll
        for (int i = 0; i < 8; ++i) v[z][i] = *(const f32x4*)(src + 256 * i); }
}
DI void tables_finish(const Args& a, int lane, int rp, f32x4 (&v)[2][8]) {
    if (rp >= 16384) return;
    float* SC = (float*)(a.ws + WS_PSC);
    float mx[2];
#pragma unroll
    for (int z = 0; z < 2; ++z) { float m = 0.f;
#pragma unroll
        for (int i = 0; i < 8; ++i) m = fmaxf(m, fmaxf(fmaxf(fabsf(v[z][i].x), fabsf(v[z][i].y)), fmaxf(fabsf(v[z][i].z), fabsf(v[z][i].w))));
        mx[z] = wave_max_fast(m); }
#pragma unroll
    for (int z = 0; z < 2; ++z) { const int rowi = 2 * rp + z, tb = rowi >> 14, row = rowi & 16383;
        const float scale = (mx[z] > 0.f) ? mx[z] * (1.0f / 224.0f) : 1.0f, inv = 1.0f / scale;
        unsigned char* dst = a.ws + (tb ? WS_PV : WS_PU) + ((size_t)(lane >> 5) * 16384 + row) * 128 + ((lane * 4) & 127);
#pragma unroll
        for (int i = 0; i < 8; ++i) { int t = 0; t = __builtin_amdgcn_cvt_pk_fp8_f32(v[z][i].x * inv, v[z][i].y * inv, t, false); t = __builtin_amdgcn_cvt_pk_fp8_f32(v[z][i].z * inv, v[z][i].w * inv, t, true);
            *(unsigned*)(dst + (size_t)(2 * i) * 16384 * 128) = (unsigned)t; }
        if (lane == 0) SC[rowi] = scale; }
}

DI void sort8_desc(float (&a)[8]) {
#define R_CE(i, j) { const float hi_ = fmaxf(a[i], a[j]), lo_ = fminf(a[i], a[j]); a[i] = hi_; a[j] = lo_; }
    R_CE(0, 1) R_CE(2, 3) R_CE(4, 5) R_CE(6, 7)
    R_CE(0, 2) R_CE(1, 3) R_CE(4, 6) R_CE(5, 7)
    R_CE(1, 2) R_CE(5, 6)
    R_CE(0, 4) R_CE(1, 5) R_CE(2, 6) R_CE(3, 7)
    R_CE(2, 4) R_CE(3, 5)
    R_CE(1, 2) R_CE(3, 4) R_CE(5, 6)
#undef R_CE
}
template <int NCH> DI void top16_rows(float (&a)[NCH][8], int i, float (&outv)[NCH], int (&outi)[NCH]) {
#pragma unroll
    for (int ch = 0; ch < NCH; ++ch) { outv[ch] = 0.f; outi[ch] = 0; sort8_desc(a[ch]); }
#pragma unroll 1
    for (int it = 0; it < 16; ++it) {
#pragma unroll
        for (int ch = 0; ch < NCH; ++ch) {
            const float wm = row16_max(a[ch][0]);
            const bool own = (a[ch][0] == wm);
#pragma unroll
            for (int k = 0; k < 7; ++k) a[ch][k] = own ? a[ch][k + 1] : a[ch][k];
            a[ch][7] = own ? -INFINITY : a[ch][7];
            if (i == it) { outv[ch] = __uint_as_float(__float_as_uint(wm) & ~127u); outi[ch] = (int)(__float_as_uint(wm) & 127u); }
        }
    }
}
DI void phase_route(const Args& a, const Ctx& c) {
    unsigned char* ws = a.ws;
    const float* SC = (const float*)(ws + WS_SC);
    int* EIDX = (int*)(ws + WS_EIDX); float* EGV = (float*)(ws + WS_EGV);
    const int lane = c.lane, r = lane >> 4, i = lane & 15, rowbase = lane & 48;
    int trip = 0;
    for (int tp = c.gw; tp < MROWS / 2; tp += c.NGW, ++trip) {
        f32x4 trow[2][8];
        const int rpA = c.gw + c.NGW * (2 * trip), rpB = rpA + c.NGW;
        tables_load(a, lane, rpA, trow);
        float sc[8][8];
#pragma unroll
        for (int ch = 0; ch < 8; ++ch) { const float* sp = SC + (size_t)(2 * tp + (ch >> 2)) * 2048 + (4 * ((ch >> 1) & 1) + r) * 256 + 128 * (ch & 1);
#pragma unroll
            for (int k = 0; k < 8; ++k) sc[ch][k] = __uint_as_float((__float_as_uint(sp[i + 16 * k]) & ~127u) | (unsigned)(i + 16 * k)); }
        float tv_[8]; int ti_[8];
        top16_rows<8>(sc, i, tv_, ti_);
        tables_finish(a, lane, rpA, trow);
        tables_load(a, lane, rpB, trow);
        int p[4] = {0, 0, 0, 0}; float cand[4], tv[4] = {0.f, 0.f, 0.f, 0.f}; int tf[4] = {0, 0, 0, 0};
#pragma unroll
        for (int ps = 0; ps < 4; ++ps) cand[ps] = __uint_as_float((__float_as_uint(tv_[2 * ps] + __shfl(tv_[2 * ps + 1], rowbase)) & ~255u) | (unsigned)(i << 4));
#pragma unroll 1
        for (int it = 0; it < 16; ++it) {
#pragma unroll
            for (int ps = 0; ps < 4; ++ps) {
                const float wm = row16_max(cand[ps]);
                if (i == it) { tv[ps] = __uint_as_float(__float_as_uint(wm) & ~255u); tf[ps] = (int)(__float_as_uint(wm) & 255u); }
                if (cand[ps] == wm) p[ps] += 1;
                const float nv = __shfl(tv_[2 * ps + 1], rowbase | (p[ps] & 15));
                cand[ps] = (p[ps] < 16) ? __uint_as_float((__float_as_uint(tv_[2 * ps] + nv) & ~255u) | (unsigned)((i << 4) | p[ps])) : -INFINITY;
            }
        }
#pragma unroll
        for (int ps = 0; ps < 4; ++ps) {
            const int token = 2 * tp + (ps >> 1), h = 4 * (ps & 1) + r;
            const int ia = __shfl(ti_[2 * ps], rowbase | (tf[ps] >> 4)), ib = __shfl(ti_[2 * ps + 1], rowbase | (tf[ps] & 15));
            const float t0 = __shfl(tv[ps], rowbase);
            const float ex = __expf(tv[ps] - t0);
            const float sm = row16_sum(ex);
            const int id = ia * 128 + ib;
            const size_t o = (size_t)token * 128 + h * 16 + i;
            EIDX[o] = id; EGV[o] = ex / sm;
        }
        tables_finish(a, lane, rpB, trow);
    }
}

DI float dot16_fp8(const v4u w, const float* x) {
    float s = 0.f;
    const unsigned ww[4] = {w.x, w.y, w.z, w.w};
#pragma unroll
    for (int q = 0; q < 4; ++q) { const f32x2 lo = __builtin_amdgcn_cvt_pk_f32_fp8((int)ww[q], false), hi = __builtin_amdgcn_cvt_pk_f32_fp8((int)ww[q], true);
        s += x[4 * q] * lo.x + x[4 * q + 1] * lo.y + x[4 * q + 2] * hi.x + x[4 * q + 3] * hi.y; }
    return s;
}
DI void axpy16_fp8(const v4u w, float g, float* acc) {
    const unsigned ww[4] = {w.x, w.y, w.z, w.w};
#pragma unroll
    for (int q = 0; q < 4; ++q) { const f32x2 lo = __builtin_amdgcn_cvt_pk_f32_fp8((int)ww[q], false), hi = __builtin_amdgcn_cvt_pk_f32_fp8((int)ww[q], true);
        acc[4 * q] += g * lo.x; acc[4 * q + 1] += g * lo.y; acc[4 * q + 2] += g * hi.x; acc[4 * q + 3] += g * hi.y; }
}
DI void peer_item(const Ctx& c, int it, int& s, int& tok0) { s = 2 * (it & 7) + (it >> 8); tok0 = ((it >> 3) & 31) * 512 + c.wave * 64; }
#define PEER_PIN4(v) asm volatile("" : "+v"(v.x), "+v"(v.y), "+v"(v.z), "+v"(v.w))
DI void phase_peer_u(const Args& a, const Ctx& c) {
    unsigned char* ws = a.ws;
    const bf16* U2 = (const bf16*)(ws + WS_U2); const int* EIDX = (const int*)(ws + WS_EIDX); float* HP = (float*)(ws + WS_HP);
    const int lane = c.lane, g = lane >> 3, part = lane & 7;
#pragma unroll 1
    for (int it = c.bid; it < 512; it += c.G) {
        int s, tok0; peer_item(c, it, s, tok0);
        const unsigned char* tab = ws + WS_PU + (size_t)s * 16384 * 128 + part * 16;
        v4u idn[2][4], xn[2][2];
#define PU_REQ(tk) do { _Pragma("unroll") for (int z_ = 0; z_ < 2; ++z_) { const size_t t_ = (size_t)((tk) + z_); \
            _Pragma("unroll") for (int q_ = 0; q_ < 4; ++q_) idn[z_][q_] = *(const v4u*)(EIDX + t_ * 128 + 16 * g + 4 * q_); \
            xn[z_][0] = *(const v4u*)(U2 + t_ * 2048 + 128 * s + 16 * part); xn[z_][1] = *(const v4u*)(U2 + t_ * 2048 + 128 * s + 16 * part + 8); } } while (0)
        PU_REQ(tok0);
#pragma unroll 1
        for (int tt = 0; tt < 64; tt += 2) {
            const int token = tok0 + tt;
            v4u w[2][16]; float x[2][16];
#pragma unroll
            for (int z = 0; z < 2; ++z) {
                const unsigned idv[16] = {idn[z][0].x, idn[z][0].y, idn[z][0].z, idn[z][0].w, idn[z][1].x, idn[z][1].y, idn[z][1].z, idn[z][1].w, idn[z][2].x, idn[z][2].y, idn[z][2].z, idn[z][2].w, idn[z][3].x, idn[z][3].y, idn[z][3].z, idn[z][3].w};
#pragma unroll
                for (int i = 0; i < 16; ++i) w[z][i] = *(const v4u*)(tab + (size_t)idv[i] * 128);
                const v4u u0 = xn[z][0], u1 = xn[z][1];
                x[z][0] = bflo(u0.x); x[z][1] = bfhi(u0.x); x[z][2] = bflo(u0.y); x[z][3] = bfhi(u0.y); x[z][4] = bflo(u0.z); x[z][5] = bfhi(u0.z); x[z][6] = bflo(u0.w); x[z][7] = bfhi(u0.w);
                x[z][8] = bflo(u1.x); x[z][9] = bfhi(u1.x); x[z][10] = bflo(u1.y); x[z][11] = bfhi(u1.y); x[z][12] = bflo(u1.z); x[z][13] = bfhi(u1.z); x[z][14] = bflo(u1.w); x[z][15] = bfhi(u1.w);
            }
            if (tt + 2 < 64) PU_REQ(token + 2);
#pragma unroll
            for (int z = 0; z < 2; ++z) {
                float hv0 = 0.f, hv1 = 0.f;
#pragma unroll
                for (int i = 0; i < 16; ++i) { const float d = group8_sum(dot16_fp8(w[z][i], x[z])); if (part == (i & 7)) { if (i < 8) hv0 = d; else hv1 = d; } }
                float* hp = HP + ((size_t)s * MROWS + token + z) * 128 + 16 * g + part;
                hp[0] = hv0; hp[8] = hv1;
            }
#pragma unroll
            for (int z = 0; z < 2; ++z) { PEER_PIN4(idn[z][0]); PEER_PIN4(idn[z][1]); PEER_PIN4(idn[z][2]); PEER_PIN4(idn[z][3]); PEER_PIN4(xn[z][0]); PEER_PIN4(xn[z][1]); }
        }
#undef PU_REQ
    }
}
DI void phase_peer_h(const Args& a, const Ctx& c) {
    unsigned char* ws = a.ws;
    const float* HP = (const float*)(ws + WS_HP); const int* EIDX = (const int*)(ws + WS_EIDX); const float* PSC = (const float*)(ws + WS_PSC); const float* EGV = (const float*)(ws + WS_EGV); float* GVP = (float*)(ws + WS_GVP);
    for (int i = c.bid * 512 + c.tid; i < MROWS * 128; i += c.G * 512) {
        const int id = EIDX[i];
        float h = 0.f;
#pragma unroll
        for (int s = 0; s < 16; ++s) h += HP[(size_t)s * MROWS * 128 + i];
        h *= PSC[id];
        GVP[i] = 0.5f * h * (1.0f + erff(h * 0.70710678118654752f)) * EGV[i] * PSC[16384 + id];
    }
}
DI void phase_peer_v(const Args& a, const Ctx& c) {
    unsigned char* ws = a.ws;
    const int* EIDX = (const int*)(ws + WS_EIDX); const float* GVP = (const float*)(ws + WS_GVP); const float* mod = (const float*)(ws + WS_MOD);
    const int lane = c.lane, g = lane >> 3, part = lane & 7;
#pragma unroll 1
    for (int it = c.bid; it < 512; it += c.G) {
        int s, tok0; peer_item(c, it, s, tok0);
        const unsigned char* tab = ws + WS_PV + (size_t)s * 16384 * 128 + part * 16;
        v4u idn[4]; f32x4 gn[4];
#define PV_REQ(tk) do { const size_t t_ = (size_t)(tk); \
            _Pragma("unroll") for (int q_ = 0; q_ < 4; ++q_) { idn[q_] = *(const v4u*)(EIDX + t_ * 128 + 16 * g + 4 * q_); gn[q_] = *(const f32x4*)(GVP + t_ * 128 + 16 * g + 4 * q_); } } while (0)
        PV_REQ(tok0);
#pragma unroll 1
        for (int tt = 0; tt < 64; ++tt) {
            const int token = tok0 + tt;
            v4u w[16]; float gv[16];
            const unsigned idv[16] = {idn[0].x, idn[0].y, idn[0].z, idn[0].w, idn[1].x, idn[1].y, idn[1].z, idn[1].w, idn[2].x, idn[2].y, idn[2].z, idn[2].w, idn[3].x, idn[3].y, idn[3].z, idn[3].w};
#pragma unroll
            for (int i = 0; i < 16; ++i) w[i] = *(const v4u*)(tab + (size_t)idv[i] * 128);
#pragma unroll
            for (int q = 0; q < 4; ++q) { gv[4 * q] = gn[q].x; gv[4 * q + 1] = gn[q].y; gv[4 * q + 2] = gn[q].z; gv[4 * q + 3] = gn[q].w; }
            if (tt + 1 < 64) PV_REQ(token + 1);
            float acc[16];
#pragma unroll
            for (int i = 0; i < 16; ++i) acc[i] = 0.f;
#pragma unroll
            for (int i = 0; i < 16; ++i) axpy16_fp8(w[i], gv[i], acc);
#pragma unroll
            for (int i = 0; i < 16; ++i) { float v = acc[i]; v += dpp_mov<0x128>(v); v += __shfl_xor(v, 16); v += __shfl_xor(v, 32); acc[i] = v; }
            if (g == 0) {
                const int b = token >> 13, col = 128 * s + 16 * part;
                const float* g2 = mod + (size_t)b * 12288 + 10240 + col; float* op = a.out + (size_t)token * 2048 + col;
#pragma unroll
                for (int q = 0; q < 4; ++q) { const f32x4 xa = *(const f32x4*)(op + 4 * q), ga = *(const f32x4*)(g2 + 4 * q);
                    f32x4 o; o.x = xa.x + ga.x * acc[4 * q]; o.y = xa.y + ga.y * acc[4 * q + 1]; o.z = xa.z + ga.z * acc[4 * q + 2]; o.w = xa.w + ga.w * acc[4 * q + 3];
                    *(f32x4*)(op + 4 * q) = o; }
            }
#pragma unroll
            for (int q = 0; q < 4; ++q) { PEER_PIN4(idn[q]); PEER_PIN4(gn[q]); }
        }
#undef PV_REQ
    }
}

__global__ void __launch_bounds__(NWAVES * 64, 2) hybrid_fwd(Args args) {
    extern __shared__ __attribute__((aligned(16))) unsigned char lds[];
    Ctx c;
#define FRESH_CTX() do { int t_ = threadIdx.x; asm volatile("" : "+v"(t_)); c.lds = (LAS unsigned char*)lds; c.tid = t_; c.lane = c.tid & 63; c.wave = __builtin_amdgcn_readfirstlane(c.tid >> 6); \
    c.G = gridDim.x; c.bid = blockIdx.x; c.gw = c.bid * NWAVES + c.wave; c.NGW = c.G * NWAVES; } while (0)
    FRESH_CTX();
    volatile LAS unsigned* MISC = (volatile LAS unsigned*)(c.lds + MISC_OFF);
    unsigned char* ws = args.ws;
    unsigned* ctl = (unsigned*)(ws + WS_CTL);
    if (c.tid < 32) MISC[c.tid] = 0u;
    __syncthreads();
    XcdBarrier bar; bar.bar = ctl + CW_BAR; bar.x = 0; bar.st = nullptr;
#if !MK_PER_PHASE
    bar = xcd_barrier_post(ctl + CW_BAR, MISC + 8);
#endif
    const int lo = args.ph_lo, hi = args.ph_hi;
#ifndef PHASE_MASK
#define PHASE_MASK 0x3ffff
#endif
#define IN(k) ((((PHASE_MASK) >> (k)) & 1) && lo <= (k) && (k) < hi)
#define SEAM(k) do { if (IN(k) && IN((k) + 1)) xcd_barrier(bar); } while (0)
    const float* mod = (const float*)(ws + WS_MOD);
    LAS unsigned char* ring = c.lds;

    if (IN(0)) { FRESH_CTX(); phase_prologue(args, c); } SEAM(0);
    if (IN(1)) { FRESH_CTX(); phase_norm_mod<true>(c, args.in[0], args.in[4], mod, 0, 2048, (bf16*)(ws + WS_U16)); } SEAM(1);
    if (IN(2)) {
        pg8::Gemm g{(const pg8::bf16_t*)(ws + WS_U16), (const pg8::bf16_t*)(ws + WS_WIN), MROWS, NZ, DM / 2, nullptr, nullptr, 0x75757575u, 0x7C7C7C7Cu}; pg8::StaticOrder S; S.init(MROWS, NZ, c.G, c.bid);
        pg8::EpiZ E{(pg8::bf16_t*)(ws + WS_ZA), (pg8::bf16_t*)(ws + WS_ZB), (pg8::bf16_t*)args.out, args.in[7]};
        pg8::gemm_phase<pg8::EpiZ, pg8::StaticOrder, true, true, false, true>(ring, g, S, E);
    } SEAM(2);
    if (IN(3)) { FRESH_CTX(); phase_qknorm_prep(args, c); phase_vtranspose(args, c); } SEAM(3);
    if (IN(4)) {
        pg8::Gemm g{(const pg8::bf16_t*)(ws + WS_T), (const pg8::bf16_t*)(ws + WS_LORA), MROWS, 5120, 256};
        pg8::GroupedOrder S; S.init(MROWS, 5120, c.G, c.bid); S.a_stride = (size_t)MROWS * 256 * 2;
        pg8::EpiLora E{{(pg8::bf16_t*)(ws + WS_LWF), (pg8::bf16_t*)(ws + WS_LWB), (pg8::bf16_t*)(ws + WS_ICF), (pg8::bf16_t*)(ws + WS_ICB), (pg8::bf16_t*)(ws + WS_G)},
                       {args.in[12], args.in[12] + 1024, args.in[14], args.in[14] + 1024, args.in[14]}};
        pg8::gemm_phase<pg8::EpiLora, pg8::GroupedOrder, true, true>(ring, g, S, E);
    }
    if (IN(5)) { FRESH_CTX(); phase_na_attention(args, c); }
    do { if ((IN(4) || IN(5)) && IN(6)) xcd_barrier(bar); } while (0);
    if (IN(6)) { FRESH_CTX(); phase_scan(args, c); } SEAM(6);
    if (IN(7)) { FRESH_CTX(); phase_scan_chain(args, c); } SEAM(7);
    if (IN(8)) { FRESH_CTX(); phase_scan_fix(args, c); } SEAM(8);
    if (IN(9)) { FRESH_CTX(); phase_rwkv_post(args, c); } SEAM(9);
    if (IN(10)) {
        pg8::Gemm g{(const pg8::bf16_t*)(ws + WS_OA), (const pg8::bf16_t*)(ws + WS_WA), MROWS, DM, 1024, (const pg8::bf16_t*)(ws + WS_OB16), (const pg8::bf16_t*)(ws + WS_WB), 0x76767676u, 0x7B7B7B7Bu};
        pg8::StaticOrder S; S.init(MROWS, DM, c.G, c.bid);
        pg8::EpiGate2 E{(pg8::bf16_t*)(ws + WS_MERGED), (const pg8::bf16_t*)args.out};
        pg8::gemm_phase<pg8::EpiGate2, pg8::StaticOrder, true, true, true, true>(ring, g, S, E);
    } SEAM(10);
    if (IN(11)) {
        pg8::Gemm g{(const pg8::bf16_t*)(ws + WS_MERGED), (const pg8::bf16_t*)(ws + WS_WOUT), MROWS, DM, DM / 2, nullptr, nullptr, 0x75757575u, 0x7A7A7A7Au}; pg8::StaticOrder S; S.init(MROWS, DM, c.G, c.bid);
        pg8::EpiRes E{args.in[0], args.out, mod + 4096, 12288};
        pg8::gemm_phase<pg8::EpiRes, pg8::StaticOrder, true, true, false, true>(ring, g, S, E);
    } SEAM(11);
    if (IN(12)) { FRESH_CTX(); phase_norm_mod<false>(c, args.out, args.in[5], mod, 6144, 8192, (bf16*)(ws + WS_U2)); } SEAM(12);
    if (IN(13)) {
        pg8::Gemm g{(const pg8::bf16_t*)(ws + WS_U2), (const pg8::bf16_t*)(ws + WS_WQS), MROWS, DM, DM}; pg8::StaticOrder S; S.init(MROWS, DM, c.G, c.bid);
        pg8::EpiRes E{nullptr, (float*)(ws + WS_SC), nullptr, 0};
        pg8::gemm_phase<pg8::EpiRes, pg8::StaticOrder, true, true>(ring, g, S, E);
    } SEAM(13);
    if (IN(14)) { FRESH_CTX(); phase_route(args, c); } SEAM(14);
    if (IN(15)) { FRESH_CTX(); phase_peer_u(args, c); } SEAM(15);
    if (IN(16)) { FRESH_CTX(); phase_peer_h(args, c); } SEAM(16);
    if (IN(17)) { FRESH_CTX(); phase_peer_v(args, c); }
#undef IN
#undef SEAM
}

extern "C" void kernel_launch(void* const* d_in, const int* in_sizes, int n_in, void* d_out, int out_size, void* d_ws, size_t ws_size, hipStream_t stream) {
    static int grid = 0;
    if (grid == 0) {
        if (n_in != 30 || in_sizes[0] != MROWS * DM || out_size != MROWS * DM || ws_size < WS_END) {
            fprintf(stderr, "kernel_launch: unexpected problem (n_in %d, in0 %d, out %d, ws %zu; need ws >= %zu); nothing launched\n", n_in, n_in > 0 ? in_sizes[0] : -1, out_size, ws_size, (size_t)WS_END); grid = -1; return; }
        int dev = 0, cus = 0, per_cu = 0;
        if (hipGetDevice(&dev) != hipSuccess || hipDeviceGetAttribute(&cus, hipDeviceAttributeMultiprocessorCount, dev) != hipSuccess) { fprintf(stderr, "kernel_launch: device query failed\n"); grid = -1; return; }
        if (hipFuncSetAttribute((const void*)hybrid_fwd, hipFuncAttributeMaxDynamicSharedMemorySize, LDS_BYTES) != hipSuccess) { fprintf(stderr, "kernel_launch: hipFuncSetAttribute failed\n"); grid = -1; return; }
        if (hipOccupancyMaxActiveBlocksPerMultiprocessor(&per_cu, (const void*)hybrid_fwd, NWAVES * 64, LDS_BYTES) != hipSuccess || per_cu < 1)
            fprintf(stderr, "kernel_launch: note: occupancy query reports %d workgroups per CU\n", per_cu);
        (void)hipGetLastError();
        grid = cus;
        if (grid > 256) grid = 256;
    }
    if (grid < 0) return;
    if (hipMemsetAsync((char*)d_ws + WS_CTL, 0, CTL_ZERO_BYTES, stream) != hipSuccess) { fprintf(stderr, "kernel_launch: memset failed\n"); return; }
    Args a{};
    for (int i = 0; i < 30; ++i) a.in[i] = (const float*)d_in[i];
    a.out = (float*)d_out; a.ws = (unsigned char*)d_ws;
#if MK_PER_PHASE
    for (int p = 0; p < N_PHASES; ++p) { a.ph_lo = p; a.ph_hi = p + 1; hipLaunchKernelGGL(hybrid_fwd, dim3(grid), dim3(NWAVES * 64), LDS_BYTES, stream, a); }
#else
    a.ph_lo = 0; a.ph_hi = N_PHASES;
    hipLaunchKernelGGL(hybrid_fwd, dim3(grid), dim3(NWAVES * 64), LDS_BYTES, stream, a);
#endif
    const hipError_t le = hipPeekAtLastError();
    if (le != hipSuccess) fprintf(stderr, "kernel_launch: launch failed: %s\n", hipGetErrorName(le));
}
```
